# Optimizing an MI355X kernel written in HIP

```python
import jax, jax.numpy as jnp
from jax import lax
import numpy as np

D_MODEL = 1024
BATCH = 4
SEQ = 8192
DEPTH = 1
DEC_BATCH = 8
DEC_SEQ = 64
PAST_LEN = 2048

CHUNK = 64
HEAD_DIM = 64
RWKV_HEADS = 8
FOX_HEADS = 8
RWKV_WIDTH = RWKV_HEADS * HEAD_DIM
FOX_WIDTH = FOX_HEADS * HEAD_DIM
MIX_WIDTH = RWKV_WIDTH + FOX_WIDTH
DECAY_LORA = 64
AAA_LORA = 64
GATE_LORA = 128
RWKV_COLS = 3 * RWKV_WIDTH + DECAY_LORA + AAA_LORA + GATE_LORA
FOX_COLS = 3 * FOX_WIDTH + FOX_HEADS
IN_COLS = RWKV_COLS + FOX_COLS
RWKV_SPLITS = (RWKV_WIDTH, 2 * RWKV_WIDTH, 3 * RWKV_WIDTH,
               3 * RWKV_WIDTH + DECAY_LORA, 3 * RWKV_WIDTH + DECAY_LORA + AAA_LORA)
FOX_SPLITS = (FOX_WIDTH, 2 * FOX_WIDTH, 3 * FOX_WIDTH)
D_FF = -(-8 * D_MODEL // (3 * 256)) * 256
Q_BLOCK = 128
NORM_EPS = 1e-6
GN_EPS = 64e-5
FORGET_BIAS_INIT = 2.0

kernel_name = 'hymba_rwkv7_fox_adaln_stream_step'


def _rms_norm(x, g):
    x32 = x.astype(jnp.float32)
    y = x32 * lax.rsqrt(jnp.mean(x32 * x32, axis=-1, keepdims=True) + NORM_EPS)
    return (y * g.astype(jnp.float32)).astype(x.dtype)


def _heads(z, n_heads):
    return z.reshape(z.shape[:-1] + (n_heads, HEAD_DIM))


def _rwkv_scan(r, decay, k, v, kk, a, s0):
    def step(s, inp):
        r_t, w_t, k_t, v_t, kk_t, a_t = inp
        sa = jnp.einsum('bhvk,bhk->bhv', s, -kk_t)
        s = (s * w_t[:, :, None, :]
             + sa[..., None] * (kk_t * a_t)[:, :, None, :]
             + v_t[..., None] * k_t[:, :, None, :])
        return s, jnp.einsum('bhvk,bhk->bhv', s, r_t)
    xs = tuple(jnp.moveaxis(z, 1, 0) for z in (r, decay, k, v, kk, a))
    s_final, ys = lax.scan(step, s0, xs)
    return jnp.moveaxis(ys, 0, 1), s_final


def _fox_attend(q, k, v, lc_q, lc_k, pos_q, pos_k):
    s = jnp.einsum('bqhd,bshd->bhqs', q, k, preferred_element_type=jnp.float32) * (HEAD_DIM ** -0.5)
    decay_bias = jnp.transpose(lc_q, (0, 2, 1))[..., :, None] - jnp.transpose(lc_k, (0, 2, 1))[..., None, :]
    causal = pos_k[None, :] <= pos_q[:, None]
    p = jax.nn.softmax(jnp.where(causal, s + decay_bias, -jnp.inf), axis=-1)
    return jnp.einsum('bhqs,bshd->bqhd', p.astype(v.dtype), v)


def _fox_mixer(q, k_all, v_all, lc_all, past):
    b, t = q.shape[:2]
    lc_q = lc_all[:, past:]
    pos_k = jnp.arange(k_all.shape[1])
    pos_q = past + jnp.arange(t)
    if t <= Q_BLOCK:
        return _fox_attend(q, k_all, v_all, lc_q, lc_all, pos_q, pos_k)
    nb = t // Q_BLOCK
    qb = jnp.moveaxis(q.reshape(b, nb, Q_BLOCK, FOX_HEADS, HEAD_DIM), 1, 0)
    lb = jnp.moveaxis(lc_q.reshape(b, nb, Q_BLOCK, FOX_HEADS), 1, 0)
    pb = pos_q.reshape(nb, Q_BLOCK)
    out = lax.map(lambda blk: _fox_attend(blk[0], k_all, v_all, blk[1], lc_all, blk[2], pos_k), (qb, lb, pb))
    return jnp.moveaxis(out, 0, 1).reshape(q.shape)


def _layer(x, c, shift_prev, s_prev, k_past, v_past, logf_past,
           norm1_g, w_ada, b_ada, w_in, shift_mu, w0, w_decay_up, a0, w_aaa_up, w_gate_up,
           k_k, k_a, r_k, gn_g, gn_b, fox_q_g, fox_k_g, fox_f_b, w_out,
           norm2_g, w_ffn_gate, w_ffn_up, w_ffn_down):
    f32 = jnp.float32
    b, t, _ = x.shape
    past = k_past.shape[1]
    mod = jax.nn.silu(c) @ w_ada + b_ada
    sh1, sc1, gt1, sh2, sc2, gt2 = jnp.split(mod, 6, axis=-1)
    h = _rms_norm(x, norm1_g) * (1 + sc1[:, None]) + sh1[:, None]
    proj = h @ w_in
    p_rwkv = proj[..., :RWKV_COLS]
    p_fox = proj[..., RWKV_COLS:]

    prev = jnp.concatenate([shift_prev.astype(p_rwkv.dtype), p_rwkv[:, :-1]], axis=1)
    z = (p_rwkv + (prev - p_rwkv) * shift_mu).astype(f32)
    new_shift = p_rwkv[:, -1:]
    r, k, v, dw, da, dg = jnp.split(z, list(RWKV_SPLITS), axis=-1)
    w_log = -jax.nn.softplus(-(w0 + jnp.tanh(dw) @ w_decay_up)) - 0.5
    decay = jnp.exp(-jnp.exp(w_log))
    a = jax.nn.sigmoid(a0 + da @ w_aaa_up)
    g = jax.nn.sigmoid(dg) @ w_gate_up
    kk = _heads(k * k_k, RWKV_HEADS)
    kk = kk / jnp.maximum(jnp.linalg.norm(kk, axis=-1, keepdims=True), 1e-12)
    k = k * (1 + (a - 1) * k_a)
    rh, kh, vh = _heads(r, RWKV_HEADS), _heads(k, RWKV_HEADS), _heads(v, RWKV_HEADS)
    y, s_new = _rwkv_scan(rh, _heads(decay, RWKV_HEADS), kh, vh, kk, _heads(a, RWKV_HEADS),
                          s_prev.astype(f32))
    mu = jnp.mean(y, axis=-1, keepdims=True)
    var = jnp.mean(jnp.square(y - mu), axis=-1, keepdims=True)
    y = ((y - mu) * lax.rsqrt(var + GN_EPS)).reshape(b, t, RWKV_WIDTH) * gn_g + gn_b
    bonus = (jnp.sum(rh * kh * r_k, axis=-1, keepdims=True) * vh).reshape(b, t, RWKV_WIDTH)
    y_rwkv = ((y + bonus) * g).astype(x.dtype)

    q, kf, vf, fl = jnp.split(p_fox, list(FOX_SPLITS), axis=-1)
    q = _rms_norm(_heads(q, FOX_HEADS), fox_q_g)
    kf = _rms_norm(_heads(kf, FOX_HEADS), fox_k_g)
    vf = _heads(vf, FOX_HEADS)
    logf = jax.nn.log_sigmoid((fl + fox_f_b).astype(f32))
    k_all = jnp.concatenate([k_past.astype(kf.dtype), kf], axis=1)
    v_all = jnp.concatenate([v_past.astype(vf.dtype), vf], axis=1)
    lc_all = jnp.cumsum(jnp.concatenate([logf_past.astype(f32), logf], axis=1), axis=1)
    y_fox = _fox_mixer(q, k_all, v_all, lc_all, past).reshape(b, t, FOX_WIDTH).astype(x.dtype)

    mix = jnp.concatenate([y_rwkv, y_fox], axis=-1) @ w_out
    x = x + gt1[:, None] * mix
    h2 = _rms_norm(x, norm2_g) * (1 + sc2[:, None]) + sh2[:, None]
    ffn = (jax.nn.silu(h2 @ w_ffn_gate) * (h2 @ w_ffn_up)) @ w_ffn_down
    x = x + gt2[:, None] * ffn
    return (x, s_new.astype(s_prev.dtype), new_shift.astype(shift_prev.dtype), kf, vf,
            logf.astype(logf_past.dtype))


def setup_inputs(seed: int = 0) -> dict:
    key = jax.random.key(seed)
    ks = jax.random.split(key, 32)
    f32 = jnp.float32

    def nrm(i, shape, s=1.0):
        return s * jax.random.normal(ks[i], shape, f32)

    L = DEPTH
    return {
        'x_prompt': nrm(0, (BATCH, SEQ, D_MODEL)),
        'x_sample': nrm(1, (DEC_BATCH, DEC_SEQ, D_MODEL)),
        'cache_fox_k': nrm(2, (L, DEC_BATCH, PAST_LEN, FOX_HEADS, HEAD_DIM)),
        'cache_fox_v': nrm(3, (L, DEC_BATCH, PAST_LEN, FOX_HEADS, HEAD_DIM)),
        'cache_fox_logf': jax.nn.log_sigmoid(FORGET_BIAS_INIT + nrm(4, (L, DEC_BATCH, PAST_LEN, FOX_HEADS))),
        'state_rwkv': nrm(5, (L, DEC_BATCH, RWKV_HEADS, HEAD_DIM, HEAD_DIM), 0.5),
        'state_rwkv_shift': nrm(6, (L, DEC_BATCH, 1, RWKV_COLS)),
        'c_prompt': nrm(7, (BATCH, D_MODEL)),
        'c_sample': nrm(8, (DEC_BATCH, D_MODEL)),
        'norm1_g': 1.0 + nrm(9, (L, D_MODEL), 0.1),
        'w_ada': nrm(10, (L, D_MODEL, 6 * D_MODEL), 0.5 * D_MODEL ** -0.5),
        'b_ada': nrm(11, (L, 6 * D_MODEL), 0.01),
        'w_in': nrm(12, (L, D_MODEL, IN_COLS), D_MODEL ** -0.5),
        'shift_mu': jax.random.uniform(ks[13], (L, RWKV_COLS), f32),
        'w0': nrm(14, (L, RWKV_WIDTH), 0.5),
        'w_decay_up': nrm(15, (L, DECAY_LORA, RWKV_WIDTH), 0.5 * DECAY_LORA ** -0.5),
        'a0': nrm(16, (L, RWKV_WIDTH), 0.5),
        'w_aaa_up': nrm(17, (L, AAA_LORA, RWKV_WIDTH), AAA_LORA ** -0.5),
        'w_gate_up': nrm(18, (L, GATE_LORA, RWKV_WIDTH), GATE_LORA ** -0.5),
        'k_k': 1.0 + nrm(19, (L, RWKV_WIDTH), 0.1),
        'k_a': 1.0 + nrm(20, (L, RWKV_WIDTH), 0.1),
        'r_k': nrm(21, (L, RWKV_HEADS, HEAD_DIM), 0.1),
        'gn_g': 1.0 + nrm(22, (L, RWKV_WIDTH), 0.1),
        'gn_b': nrm(23, (L, RWKV_WIDTH), 0.01),
        'fox_q_g': 1.0 + nrm(24, (L, HEAD_DIM), 0.1),
        'fox_k_g': 1.0 + nrm(25, (L, HEAD_DIM), 0.1),
        'fox_f_b': FORGET_BIAS_INIT + nrm(26, (L, FOX_HEADS), 0.5),
        'w_out': nrm(27, (L, MIX_WIDTH, D_MODEL), MIX_WIDTH ** -0.5),
        'norm2_g': 1.0 + nrm(28, (L, D_MODEL), 0.1),
        'w_ffn_gate': nrm(29, (L, D_MODEL, D_FF), D_MODEL ** -0.5),
        'w_ffn_up': nrm(30, (L, D_MODEL, D_FF), D_MODEL ** -0.5),
        'w_ffn_down': nrm(31, (L, D_FF, D_MODEL), D_FF ** -0.5),
    }


def reference(x_prompt, x_sample, cache_fox_k, cache_fox_v, cache_fox_logf, state_rwkv, state_rwkv_shift,
              c_prompt, c_sample, norm1_g, w_ada, b_ada, w_in, shift_mu, w0, w_decay_up, a0, w_aaa_up,
              w_gate_up, k_k, k_a, r_k, gn_g, gn_b, fox_q_g, fox_k_g, fox_f_b, w_out, norm2_g,
              w_ffn_gate, w_ffn_up, w_ffn_down):
    assert x_sample.shape[1] <= CHUNK
    bp = x_prompt.shape[0]
    zero_shift = jnp.zeros((bp, 1, RWKV_COLS), state_rwkv_shift.dtype)
    zero_state = jnp.zeros((bp, RWKV_HEADS, HEAD_DIM, HEAD_DIM), state_rwkv.dtype)
    zero_kv = jnp.zeros((bp, 0, FOX_HEADS, HEAD_DIM), cache_fox_k.dtype)
    zero_logf = jnp.zeros((bp, 0, FOX_HEADS), cache_fox_logf.dtype)
    hp, hs = x_prompt, x_sample
    rs_p, sh_p, k_p, v_p, lf_p = [], [], [], [], []
    rs_s, sh_s, k_s, v_s, lf_s = [], [], [], [], []
    for l in range(DEPTH):
        lw = (norm1_g[l], w_ada[l], b_ada[l], w_in[l], shift_mu[l], w0[l], w_decay_up[l], a0[l],
              w_aaa_up[l], w_gate_up[l], k_k[l], k_a[l], r_k[l], gn_g[l], gn_b[l], fox_q_g[l],
              fox_k_g[l], fox_f_b[l], w_out[l], norm2_g[l], w_ffn_gate[l], w_ffn_up[l], w_ffn_down[l])
        hp, s1, s2, s3, s4, s5 = _layer(hp, c_prompt, zero_shift, zero_state, zero_kv, zero_kv, zero_logf, *lw)
        rs_p.append(s1); sh_p.append(s2); k_p.append(s3); v_p.append(s4); lf_p.append(s5)
        hs, u1, u2, u3, u4, u5 = _layer(hs, c_sample, state_rwkv_shift[l], state_rwkv[l], cache_fox_k[l],
                                        cache_fox_v[l], cache_fox_logf[l], *lw)
        rs_s.append(u1); sh_s.append(u2); k_s.append(u3); v_s.append(u4); lf_s.append(u5)
    y_prompt, y_sample = hp, hs
    rwkv_state_p, rwkv_shift_p = jnp.stack(rs_p), jnp.stack(sh_p)
    fox_k_p, fox_v_p, fox_logf_p = jnp.stack(k_p), jnp.stack(v_p), jnp.stack(lf_p)
    rwkv_state_s, rwkv_shift_s = jnp.stack(rs_s), jnp.stack(sh_s)
    fox_k_s, fox_v_s, fox_logf_s = jnp.stack(k_s), jnp.stack(v_s), jnp.stack(lf_s)
    return (y_prompt, y_sample, rwkv_state_p, rwkv_shift_p, fox_k_p, fox_v_p, fox_logf_p,
            rwkv_state_s, rwkv_shift_s, fox_k_s, fox_v_s, fox_logf_s)
```

```cpp
#include <hip/hip_runtime.h>
#include <hip/hip_cooperative_groups.h>
#include <cstdint>
#include <cstdio>
namespace cg = cooperative_groups;

#define LAS __attribute__((address_space(3)))
typedef unsigned short bf16_t;
typedef short bf16x8 __attribute__((ext_vector_type(8)));
typedef float f32x4 __attribute__((ext_vector_type(4)));
typedef float f32x2 __attribute__((ext_vector_type(2)));
typedef float f32x16 __attribute__((ext_vector_type(16)));
typedef unsigned u32x4 __attribute__((ext_vector_type(4)));
typedef unsigned u32x2 __attribute__((ext_vector_type(2)));
typedef short v4i16_t __attribute__((ext_vector_type(4)));

#ifndef REP_GEMM
#define REP_GEMM 1
#endif
#ifndef REP_SCAN
#define REP_SCAN 1
#endif
#ifndef REP_ROWS
#define REP_ROWS 1
#endif
constexpr int DM = 1024, TP = 8192, BP = 4, BS = 8, TS = 64, PAST = 2048, NKS = PAST + TS;
constexpr int MP = BP * TP, MS = BS * TS, MT = MP + MS;
constexpr int RC = 1792, INC = 3336, NPAD = 3584, DFF = 2816;
constexpr float LOG2E = 1.4426950408889634f;
constexpr float QSCALE = 0.125f * LOG2E;
constexpr size_t O_Y = 0, O_STP = 34078720, O_SHP = 34209792, O_KP = 34216960, O_VP = 50994176, O_LFP = 67771392,
                 O_STS = 68033536, O_SHS = 68295680, O_KS = 68310016, O_VS = 68572160, O_LFS = 68834304;
constexpr size_t KiB = 1024, MiB = 1u << 20;
constexpr size_t WS_CTL = 0, WS_MOD = 1 * MiB, WS_RK = 2 * MiB, WS_LCP = 3 * MiB + 256 * KiB, WS_LCS = 4 * MiB + 512 * KiB;
constexpr size_t WS_WIN = 6 * MiB, WS_WO = 13 * MiB, WS_WGU = 15 * MiB, WS_WD = 26 * MiB, WS_WL = 31 * MiB + 512 * KiB;
constexpr size_t WS_XN = 33 * MiB, WS_PR = 98 * MiB, WS_A2 = 211 * MiB + 768 * KiB, WS_PF = 228 * MiB;
constexpr size_t WS_WDEC = 341 * MiB + 768 * KiB, WS_AG = 406 * MiB + 768 * KiB, WS_KS = 471 * MiB + 768 * KiB, WS_VS = 488 * MiB + 256 * KiB;
constexpr size_t WS_END = 509 * MiB + 768 * KiB;
constexpr size_t WS_Y = WS_XN, WS_X1 = WS_PR, WS_ACT = WS_PF;
constexpr size_t WS_ACTG = WS_KS, WS_H2G = WS_A2;
static_assert(WS_PR + (size_t)MT * RC * 2 == WS_A2 && WS_A2 + (size_t)MT * 256 * 2 == WS_PF && WS_PF + (size_t)MT * RC * 2 == WS_WDEC, "ws map");
static_assert(WS_WDEC + (size_t)MT * 512 * 4 == WS_AG && WS_AG + (size_t)MT * 1024 * 2 == WS_KS && WS_X1 + (size_t)MT * 1024 * 4 == WS_PF, "ws map");
static_assert(WS_ACT + (size_t)MT * DFF * 2 == WS_AG && WS_XN + (size_t)MT * 1024 * 2 == WS_PR, "ws map");
constexpr int LDS_BYTES = 147456;

__device__ __forceinline__ float bflo(unsigned u) { return __uint_as_float(u << 16); }
__device__ __forceinline__ float bfhi(unsigned u) { return __uint_as_float(u & 0xffff0000u); }
__device__ __forceinline__ float bf1(bf16_t b) { return __uint_as_float(((unsigned)b) << 16); }
__device__ __forceinline__ unsigned f2bf(float f) { unsigned u = __float_as_uint(f); return (u + 0x7fffu + ((u >> 16) & 1u)) >> 16; }
__device__ __forceinline__ unsigned pk2(float lo, float hi) { return f2bf(lo) | (f2bf(hi) << 16); }
__device__ __forceinline__ void unpack8(u32x4 u, float* f) { f[0] = bflo(u.x); f[1] = bfhi(u.x); f[2] = bflo(u.y); f[3] = bfhi(u.y); f[4] = bflo(u.z); f[5] = bfhi(u.z); f[6] = bflo(u.w); f[7] = bfhi(u.w); }
__device__ __forceinline__ u32x4 pack8(const float* f) { u32x4 o; o.x = pk2(f[0], f[1]); o.y = pk2(f[2], f[3]); o.z = pk2(f[4], f[5]); o.w = pk2(f[6], f[7]); return o; }
__device__ __forceinline__ float wave_sum(float v) {
#pragma unroll
    for (int o = 1; o < 64; o <<= 1) v += __shfl_xor(v, o);
    return v;
}
__device__ __forceinline__ float sum8(float v) { v += __shfl_xor(v, 1); v += __shfl_xor(v, 2); v += __shfl_xor(v, 4); return v; }
__device__ __forceinline__ float sigmoidf_(float x) { return 1.0f / (1.0f + __expf(-x)); }
template <int CTRL> __device__ __forceinline__ float dppf(float x) { return __builtin_bit_cast(float, __builtin_amdgcn_update_dpp(0, __builtin_bit_cast(int, x), CTRL, 0xf, 0xf, true)); }
__device__ __forceinline__ float allsum16(float v) {
    v += dppf<0xB1>(v); v += dppf<0x4E>(v); v += dppf<0x141>(v); v += dppf<0x140>(v); return v;
}
__device__ __forceinline__ int batch_of_row(int m) { return m < MP ? (m >> 13) : 4 + ((m - MP) >> 6); }


__device__ __forceinline__ void cbar(unsigned* ctr, unsigned target) {
    asm volatile("s_waitcnt vmcnt(0)" ::: "memory");
    __syncthreads();
    if (threadIdx.x == 0) {
        __builtin_amdgcn_fence(__ATOMIC_RELEASE, "agent");
        asm volatile("s_waitcnt vmcnt(0)" ::: "memory");
        __hip_atomic_fetch_add(ctr, 1u, __ATOMIC_RELAXED, __HIP_MEMORY_SCOPE_AGENT);
        while (__hip_atomic_load(ctr, __ATOMIC_RELAXED, __HIP_MEMORY_SCOPE_AGENT) < target) __builtin_amdgcn_s_sleep(2);
        __builtin_amdgcn_fence(__ATOMIC_ACQUIRE, "agent");
        asm volatile("s_waitcnt vmcnt(0)" ::: "memory");
    }
    __syncthreads();
}

#define XB_TMO      128
#define XB_XCNT(j)  (256  + 64 * (j))
#define XB_XSUB(j)  (1280 + 64 * (j))
#define XB_XGEN(j)  (2304 + 64 * (j))
#define XB_TOP      3328
#define XB_TOPGEN   3392
#define XCD_BAR_WORDS 3456
#define XB_SPIN_CAP (1u << 22)
__device__ __forceinline__ unsigned xb_ld(unsigned* p)              { return __hip_atomic_load(p, __ATOMIC_RELAXED, __HIP_MEMORY_SCOPE_AGENT); }
__device__ __forceinline__ unsigned xb_add(unsigned* p, unsigned v) { return __hip_atomic_fetch_add(p, v, __ATOMIC_RELAXED, __HIP_MEMORY_SCOPE_AGENT); }
__device__ __forceinline__ unsigned xb_xcc_id() { return (unsigned)__builtin_amdgcn_s_getreg((3 << 11) | 20) & 0xFu; }
#define XB_SPIN(cond, bar) do { unsigned _sp = 0; while (cond) { __builtin_amdgcn_s_sleep(1); \
    if ((++_sp & 255u) == 0u) { if (xb_ld(&(bar)[XB_TMO])) break; if (_sp > XB_SPIN_CAP) { atomicAdd(&(bar)[XB_TMO], 1u); break; } } } } while (0)
struct XcdBarrier { unsigned* bar; unsigned x; volatile LAS unsigned* st; };
__device__ __forceinline__ XcdBarrier xcd_barrier_post(unsigned* bar, volatile LAS unsigned* st) {
    XcdBarrier b; b.bar = bar; b.x = xb_xcc_id(); b.st = st;
    if (threadIdx.x == 0) (void)xb_add(&bar[XB_XCNT(b.x)], 1u);
    return b;
}
__device__ __forceinline__ void xcd_barrier_complete(unsigned* bar, unsigned x, unsigned& nloc, unsigned& nx) {
    const unsigned Gn = gridDim.x * gridDim.y * gridDim.z;
    unsigned sum, cnt, mine, sp = 0u;
    for (;;) {
        sum = 0u; cnt = 0u; mine = 0u;
#pragma unroll
        for (unsigned j = 0; j < 16; ++j) { const unsigned c = xb_ld(&bar[XB_XCNT(j)]); sum += c; cnt += (c > 0u) ? 1u : 0u; mine = (j == x) ? c : mine; }
        if (sum == Gn) break;
        __builtin_amdgcn_s_sleep(1);
        if ((++sp & 255u) == 0u) { if (xb_ld(&bar[XB_TMO])) break; if (sp > XB_SPIN_CAP) { atomicAdd(&bar[XB_TMO], 1u); break; } }
    }
    nloc = mine > 0u ? mine : 1u; nx = cnt > 0u ? cnt : 1u;
}
__device__ __forceinline__ void xcd_barrier(const XcdBarrier& b, bool first) {
    asm volatile("s_waitcnt vmcnt(0)" ::: "memory");
    __syncthreads();
    if (threadIdx.x == 0) {
        unsigned* bar = b.bar;
        __builtin_amdgcn_s_waitcnt(0);
        unsigned nloc = first ? 0u : b.st[0], nx = first ? 0u : b.st[1];
        if (first) (void)xb_add(&bar[XB_XCNT(b.x)], 1u);
        if (nloc == 0u) { xcd_barrier_complete(bar, b.x, nloc, nx); b.st[0] = nloc; b.st[1] = nx; }
        const unsigned old = xb_add(&bar[XB_XSUB(b.x)], 1u);
        const unsigned gen = old / nloc;
        if (old + 1u == (gen + 1u) * nloc) {
            __builtin_amdgcn_fence(__ATOMIC_RELEASE, "agent");
            asm volatile("s_waitcnt vmcnt(0)" ::: "memory");
            const unsigned og = xb_add(&bar[XB_TOP], 1u);
            const unsigned tg = og / nx;
            if (og + 1u == (tg + 1u) * nx) xb_add(&bar[XB_TOPGEN], 1u);
            else XB_SPIN(xb_ld(&bar[XB_TOPGEN]) == tg, bar);
            __builtin_amdgcn_fence(__ATOMIC_ACQUIRE, "agent");
            xb_add(&bar[XB_XGEN(b.x)], 1u);
            asm volatile("s_waitcnt vmcnt(0)" ::: "memory");
        } else {
            XB_SPIN(xb_ld(&bar[XB_XGEN(b.x)]) == gen, bar);
            __builtin_amdgcn_fence(__ATOMIC_ACQUIRE, "agent");
            asm volatile("s_waitcnt vmcnt(0)" ::: "memory");
        }
    }
    __syncthreads();
}

namespace pg8 {
constexpr int BM = 256, BK = 64, HALF = 128, HTB = HALF * BK * 2, STAGE_BYTES = 8 * HTB, NXCD = 8, WGM = 8;
__host__ __device__ __forceinline__ int lds_byte(int r, int c) { const int st = (r >> 4) * 2 + (c >> 5), rr = r & 15, cc = c & 31, ob = rr * 64 + cc * 2; return st * 1024 + (ob ^ (((ob >> 9) & 1) << 5)); }
__host__ __device__ __forceinline__ void stage_rc(int b, int& R, int& C) { const int st = b / 1024, sb = b % 1024, swz = sb ^ (((sb >> 9) & 1) << 5); R = (st >> 1) * 16 + swz / 64; C = (st & 1) * 32 + (swz % 64) / 2; }
__host__ __device__ __forceinline__ int perm32(int rho) { const int n = rho >> 4, i = rho & 15; return 8 * (i >> 2) + 4 * n + (i & 3); }
struct Unit { int pm, pn, pg, pb; };
struct Gemm { const bf16_t* A; const bf16_t* Bt; int M, N, K, lda; };
struct StaticOrder {
    int nM, nN, nwg, G, c;
    __device__ void init(int M, int N, int G_, int c_) { nM = M / BM; nN = N / BM; nwg = nM * nN; G = G_; c = c_; }
    __device__ bool next(int i, Unit& u) const {
        const long L = (long)i * G + c; if (L >= (long)nwg * REP_GEMM) return false;
        int wgid = (int)(L % nwg); { const int q = nwg / NXCD, r = nwg % NXCD, xcd = wgid % NXCD, off = wgid / NXCD; wgid = (xcd < r ? xcd * (q + 1) : r * (q + 1) + (xcd - r) * q) + off; }
        const int nig = WGM * nN, gid = wgid / nig, fm = gid * WGM, gsz = (nM - fm) < WGM ? (nM - fm) : WGM;
        u.pm = fm + ((wgid % nig) % gsz); u.pn = (wgid % nig) / gsz; u.pg = u.pm; u.pb = u.pm; return true;
    }
};

struct RowSet {
    int rest, g;
    __device__ __forceinline__ int ntiles() const { return MT / 256; }
    __device__ __forceinline__ int nrows() const { return MT; }
    __device__ __forceinline__ int gtile(int rt) const { return rt; }
    __device__ __forceinline__ int grow(int r) const { return r; }
    __device__ __forceinline__ int brow(int r) const { return r; }
};
struct MapOrder {
    RowSet rs; int nN, pool, rank, a_global;
    __device__ bool next(int i, Unit& u) const {
        const int L = i * pool + rank; if (L >= rs.ntiles() * nN) return false;
        const int rt = L / nN; u.pn = L % nN; u.pg = rs.gtile(rt); u.pb = u.pg; u.pm = a_global ? u.pg : u.pb; return true;
    }
};
__device__ __forceinline__ unsigned cvt_pk_bf16(float lo, float hi) { unsigned r; asm volatile("v_cvt_pk_bf16_f32 %0, %1, %2" : "=v"(r) : "v"(lo), "v"(hi)); return r; }

struct EpiProj {
    static constexpr bool PERM = true;
    bf16_t* PR; bf16_t* PF;
    __device__ __forceinline__ void operator()(const f32x4 (&acc)[2][2][4][2], const Unit& u, int wr, int wc, int fr, int fq) const {
        int colt = u.pn * BM; bf16_t* base = PR; if (colt >= RC) { base = PF; colt -= RC; }
        const int row0 = u.pm * BM + wr * 64 + fr, col0 = colt + wc * 32 + 8 * fq;
#pragma unroll
        for (int ai = 0; ai < 2; ++ai)
#pragma unroll
            for (int m = 0; m < 4; ++m) { bf16_t* rowp = base + (size_t)(row0 + ai * HALF + m * 16) * RC + col0;
#pragma unroll
                for (int bj = 0; bj < 2; ++bj) { const f32x4 v0 = acc[ai][bj][m][0], v1 = acc[ai][bj][m][1]; u32x4 w;
                    w.x = cvt_pk_bf16(v0[0], v0[1]); w.y = cvt_pk_bf16(v0[2], v0[3]); w.z = cvt_pk_bf16(v1[0], v1[1]); w.w = cvt_pk_bf16(v1[2], v1[3]);
                    *(u32x4*)(rowp + bj * HALF) = w; } }
    }
};
struct EpiLora {
    static constexpr bool PERM = false;
    float* Wdec; bf16_t* AG; const float* w0; const float* a0;
    __device__ __forceinline__ void operator()(const f32x4 (&acc)[2][2][4][2], const Unit& u, int wr, int wc, int fr, int fq) const {
        const int type = u.pn >> 1, cbase = (u.pn & 1) * BM + wc * 32 + 4 * fq, row0 = u.pm * BM + wr * 64 + fr;
#pragma unroll
        for (int bj = 0; bj < 2; ++bj)
#pragma unroll
            for (int n = 0; n < 2; ++n) { const int ch = cbase + bj * HALF + n * 16;
                f32x4 bias = (f32x4){0.f, 0.f, 0.f, 0.f};
                if (type == 0) bias = *(const f32x4*)(w0 + ch); else if (type == 1) bias = *(const f32x4*)(a0 + ch);
#pragma unroll
                for (int ai = 0; ai < 2; ++ai)
#pragma unroll
                    for (int m = 0; m < 4; ++m) { const size_t row = (size_t)(row0 + ai * HALF + m * 16); f32x4 v = acc[ai][bj][m][n] + bias;
                        if (type == 0) { f32x4 o;
#pragma unroll
                            for (int j = 0; j < 4; ++j) o[j] = __expf(-0.6065306597126334f * sigmoidf_(v[j]));
                            *(f32x4*)(Wdec + row * 512 + ch) = o; }
                        else { if (type == 1) {
#pragma unroll
                                for (int j = 0; j < 4; ++j) v[j] = sigmoidf_(v[j]); }
                            u32x2 w; w.x = cvt_pk_bf16(v[0], v[1]); w.y = cvt_pk_bf16(v[2], v[3]);
                            *(u32x2*)(AG + row * 1024 + (type == 2 ? 512 : 0) + ch) = w; } } }
    }
};
struct EpiResid {
    static constexpr bool PERM = false;
    const float* base_p; const float* base_s; const float* base_buf; float* out_final; float* out_buf; const float* gate;
    __device__ __forceinline__ void operator()(const f32x4 (&acc)[2][2][4][2], const Unit& u, int wr, int wc, int fr, int fq) const {
        const int col0 = u.pn * BM + wc * 32 + 4 * fq;
#pragma unroll
        for (int ai = 0; ai < 2; ++ai)
#pragma unroll
            for (int m = 0; m < 4; ++m) { const int rl = ai * HALF + wr * 64 + m * 16 + fr, row = u.pg * BM + rl, rowb = u.pb * BM + rl;
                const float* bp = (base_buf ? base_buf + (size_t)rowb * DM : (row < MP ? base_p + (size_t)row * DM : base_s + (size_t)(row - MP) * DM)) + col0;
                const float* gp = gate + (size_t)batch_of_row(row) * 6144 + col0; float* op = (out_final ? out_final + (size_t)row * DM : out_buf + (size_t)rowb * DM) + col0;
#pragma unroll
                for (int bj = 0; bj < 2; ++bj)
#pragma unroll
                    for (int n = 0; n < 2; ++n) { const int o = bj * HALF + n * 16; const f32x4 b = *(const f32x4*)(bp + o), g = *(const f32x4*)(gp + o);
                        *(f32x4*)(op + o) = b + g * acc[ai][bj][m][n]; } }
    }
};
struct EpiSwiglu {
    static constexpr bool PERM = true;
    bf16_t* ACT;
    __device__ __forceinline__ void operator()(const f32x4 (&acc)[2][2][4][2], const Unit& u, int wr, int wc, int fr, int fq) const {
        const int row0 = u.pb * BM + wr * 64 + fr, col0 = u.pn * HALF + wc * 32 + 8 * fq;
#pragma unroll
        for (int ai = 0; ai < 2; ++ai)
#pragma unroll
            for (int m = 0; m < 4; ++m) { float r[8];
#pragma unroll
                for (int n = 0; n < 2; ++n)
#pragma unroll
                    for (int j = 0; j < 4; ++j) { const float g = acc[ai][0][m][n][j], up = acc[ai][1][m][n][j]; r[n * 4 + j] = g * __builtin_amdgcn_rcpf(1.0f + __expf(-g)) * up; }
                u32x4 w; w.x = cvt_pk_bf16(r[0], r[1]); w.y = cvt_pk_bf16(r[2], r[3]); w.z = cvt_pk_bf16(r[4], r[5]); w.w = cvt_pk_bf16(r[6], r[7]);
                *(u32x4*)(ACT + (size_t)(row0 + ai * HALF + m * 16) * DFF + col0) = w; }
    }
};

template <class Epi, class Sched, bool ALIGN_EPI>
__device__ __forceinline__ void gemm_phase(LAS unsigned char* lds, const Gemm g, const Sched& S, const Epi& E, int opq = 0) {
    const int tid = threadIdx.x + opq, wid = __builtin_amdgcn_readfirstlane(tid >> 6), lane = tid & 63, wr = wid >> 2, wc = wid & 3, fr = lane & 15, fq = lane >> 4;
    const int K = g.K, nt = K / BK, lda = g.lda;
    unsigned voffA[2], voffB[2];
#pragma unroll
    for (int i = 0; i < 2; ++i) { int R, C; stage_rc(tid * 16 + i * 8192, R, C); const int Rb = Epi::PERM ? ((R & ~31) + perm32(R & 31)) : R;
        voffA[i] = (unsigned)(R * lda + C) * 2u; voffB[i] = (unsigned)(Rb * K + C) * 2u; }
    const size_t kstep = (size_t)(BK * 2);
    const size_t hstepA = (size_t)HALF * lda * 2, hstepB = (size_t)HALF * K * 2;
    const size_t tstepA = 2 * hstepA, tstepB = 2 * hstepB;
    const unsigned ldsw = (unsigned)wid * 1024u;
    const int aoff = lds_byte(wr * 64 + fr, fq * 8), boff = lds_byte(wc * 32 + fr, fq * 8);
#define PG8_SA(b, h) (((b) * 2 + (h)) * HTB)
#define PG8_SB(b, h) ((4 + (b) * 2 + (h)) * HTB)
#define PG8_STAGE(bufoff, gbase, voff) do { _Pragma("unroll") for (int _i = 0; _i < 2; ++_i) \
        __builtin_amdgcn_global_load_lds((const unsigned*)((const char*)(gbase) + (voff)[_i]), (LAS unsigned*)(lds + (bufoff) + ldsw + _i * 8192), 16, 0, 0); } while (0)
#define PG8_LDA(dst, b, h) do { _Pragma("unroll") for (int m = 0; m < 4; ++m) _Pragma("unroll") for (int k = 0; k < 2; ++k) dst[m][k] = *(const LAS bf16x8*)(lds + PG8_SA(b, h) + aoff + m * 2048 + k * 1024); } while (0)
#define PG8_LDB(dst, b, h) do { _Pragma("unroll") for (int n = 0; n < 2; ++n) _Pragma("unroll") for (int k = 0; k < 2; ++k) dst[n][k] = *(const LAS bf16x8*)(lds + PG8_SB(b, h) + boff + n * 2048 + k * 1024); } while (0)
#define PG8_MMA(ai, bj, At, Bt) do { __builtin_amdgcn_s_setprio(1); _Pragma("unroll") for (int m = 0; m < 4; ++m) _Pragma("unroll") for (int n = 0; n < 2; ++n) _Pragma("unroll") for (int k = 0; k < 2; ++k) \
        acc[ai][bj][m][n] = __builtin_amdgcn_mfma_f32_16x16x32_bf16(Bt[n][k], At[m][k], acc[ai][bj][m][n], 0, 0, 0); __builtin_amdgcn_s_setprio(0); } while (0)
#define PG8_WAIT_V(n) asm volatile("s_waitcnt vmcnt(" #n ")" ::: "memory")
#define PG8_WAIT_L(n) asm volatile("s_waitcnt lgkmcnt(" #n ")" ::: "memory")
#define PG8_BAR __builtin_amdgcn_s_barrier()
#define PG8_SCHED __builtin_amdgcn_sched_barrier(0)
    Unit cur, nxt; int ui = 0;
    if (!S.next(0, cur)) return;
    f32x4 acc[2][2][4][2];
#pragma unroll
    for (int a = 0; a < 2; ++a)
#pragma unroll
        for (int b = 0; b < 2; ++b)
#pragma unroll
            for (int m = 0; m < 4; ++m)
#pragma unroll
                for (int n = 0; n < 2; ++n) acc[a][b][m][n] = (f32x4){0.f, 0.f, 0.f, 0.f};
    bf16x8 At[4][2], B0[2][2], B1[2][2];
    const char* cA = (const char*)g.A + (size_t)cur.pm * tstepA; const char* cB = (const char*)g.Bt + (size_t)cur.pn * tstepB;
    PG8_STAGE(PG8_SB(0, 0), cB, voffB); PG8_STAGE(PG8_SB(0, 1), cB + hstepB, voffB); PG8_STAGE(PG8_SA(0, 0), cA, voffA); PG8_STAGE(PG8_SA(0, 1), cA + hstepA, voffA);
    if (wr == 1) PG8_BAR;
    PG8_WAIT_V(2); PG8_BAR;
    PG8_STAGE(PG8_SB(1, 0), cB + kstep, voffB); PG8_STAGE(PG8_SA(1, 0), cA + kstep, voffA); PG8_STAGE(PG8_SB(1, 1), cB + hstepB + kstep, voffB);
    PG8_WAIT_V(6); PG8_BAR;
    for (;;) {
        const bool has_next = S.next(ui + 1, nxt);
        const char* nA = has_next ? (const char*)g.A + (size_t)nxt.pm * tstepA : cA; const char* nB = has_next ? (const char*)g.Bt + (size_t)nxt.pn * tstepB : cB;
        for (int t = 0; t < nt; t += 2) {
            const bool last = (t == nt - 2);
            const char* a1 = cA + (size_t)(t + 1) * kstep;
            const char* a2 = last ? nA : cA + (size_t)(t + 2) * kstep; const char* b2 = last ? nB : cB + (size_t)(t + 2) * kstep;
            const char* a3 = a2 + kstep; const char* b3 = b2 + kstep;
            PG8_LDB(B0, 0, 0); PG8_LDB(B1, 0, 1); PG8_SCHED; PG8_LDA(At, 0, 0); PG8_STAGE(PG8_SA(1, 1), a1 + hstepA, voffA);
            PG8_WAIT_V(8); PG8_WAIT_L(0); PG8_BAR; PG8_MMA(0, 0, At, B0); PG8_MMA(0, 1, At, B1); PG8_BAR; PG8_SCHED;
            PG8_LDA(At, 0, 1); PG8_STAGE(PG8_SB(0, 0), b2, voffB); PG8_STAGE(PG8_SB(0, 1), b2 + hstepB, voffB); PG8_STAGE(PG8_SA(0, 0), a2, voffA);
            PG8_WAIT_V(8); PG8_WAIT_L(0); PG8_BAR; PG8_MMA(1, 0, At, B0); PG8_MMA(1, 1, At, B1); PG8_BAR; PG8_SCHED;
            PG8_LDB(B0, 1, 0); PG8_LDB(B1, 1, 1); PG8_SCHED; PG8_LDA(At, 1, 0); PG8_STAGE(PG8_SA(0, 1), a2 + hstepA, voffA);
            PG8_WAIT_V(8); PG8_WAIT_L(0); PG8_BAR; PG8_MMA(0, 0, At, B0); PG8_MMA(0, 1, At, B1); PG8_BAR; PG8_SCHED;
            PG8_LDA(At, 1, 1); PG8_STAGE(PG8_SB(1, 0), b3, voffB); PG8_STAGE(PG8_SB(1, 1), b3 + hstepB, voffB); PG8_STAGE(PG8_SA(1, 0), a3, voffA);
            PG8_WAIT_V(8); PG8_WAIT_L(0); PG8_BAR; PG8_MMA(1, 0, At, B0); PG8_MMA(1, 1, At, B1); PG8_BAR; PG8_SCHED;
        }
        if constexpr (ALIGN_EPI) { if (wr == 0) PG8_BAR; }
        E(acc, cur, wr, wc, fr, fq);
        if (!has_next) break;
#pragma unroll
        for (int a = 0; a < 2; ++a)
#pragma unroll
            for (int b = 0; b < 2; ++b)
#pragma unroll
                for (int m = 0; m < 4; ++m)
#pragma unroll
                    for (int n = 0; n < 2; ++n) acc[a][b][m][n] = (f32x4){0.f, 0.f, 0.f, 0.f};
        cur = nxt; cA = nA; cB = nB; ++ui;
        if constexpr (ALIGN_EPI) { if (wr == 1) PG8_BAR; }
    }
    PG8_WAIT_V(0);
    if constexpr (!ALIGN_EPI) { if (wr == 0) PG8_BAR; }
    PG8_BAR;
#undef PG8_SA
#undef PG8_SB
#undef PG8_STAGE
#undef PG8_LDA
#undef PG8_LDB
#undef PG8_MMA
#undef PG8_WAIT_V
#undef PG8_WAIT_L
#undef PG8_BAR
#undef PG8_SCHED
}
}

struct Args { const float* in[32]; float* out; unsigned char* ws; int ph_lo, ph_hi; };

struct SrcPlain { const float* W; int ld, nvalid; __device__ __forceinline__ float operator()(int k, int n) const { return n < nvalid ? W[(size_t)k * ld + n] : 0.f; } };
struct SrcRot { const float* W; __device__ __forceinline__ float operator()(int k, int n) const { return W[(size_t)((k + 512) & 1023) * 1024 + n]; } };
struct SrcLora { const float* wd; const float* wa; const float* wg;
    __device__ __forceinline__ float operator()(int k, int n) const {
        if (n < 512) return k < 64 ? wd[k * 512 + n] : 0.f;
        if (n < 1024) return (k >= 64 && k < 128) ? wa[(k - 64) * 512 + (n - 512)] : 0.f;
        return k >= 128 ? wg[(k - 128) * 512 + (n - 1024)] : 0.f; } };
struct DstId { __device__ __forceinline__ int operator()(int n) const { return n; } };
struct DstGU { int add; __device__ __forceinline__ int operator()(int n) const { return (n >> 7) * 256 + (n & 127) + add; } };
template <class SrcF, class DstF>
__device__ __forceinline__ void tr_item(const SrcF& src, const DstF& drow, bf16_t* WT, int ldt, int k0, int n0, LAS float* scr, int lane) {
#pragma unroll 8
    for (int i = 0; i < 32; ++i) { const int kk = 2 * i + (lane >> 5); scr[kk * 33 + (lane & 31)] = src(k0 + kk, n0 + (lane & 31)); }
    asm volatile("s_waitcnt lgkmcnt(0)" ::: "memory");
    const int c = lane & 7;
#pragma unroll
    for (int j = 0; j < 4; ++j) { const int n = (lane >> 3) + 8 * j; const LAS float* s = scr + (8 * c) * 33 + n;
        u32x4 o; o.x = pk2(s[0 * 33], s[1 * 33]); o.y = pk2(s[2 * 33], s[3 * 33]); o.z = pk2(s[4 * 33], s[5 * 33]); o.w = pk2(s[6 * 33], s[7 * 33]);
        *(u32x4*)(WT + (size_t)drow(n0 + n) * ldt + k0 + 8 * c) = o; }
    asm volatile("s_waitcnt lgkmcnt(0)" ::: "memory");
}

__device__ __forceinline__ void phase0(const Args& a, LAS unsigned char* lds) {
    const int tid = threadIdx.x, lane = tid & 63, wid = tid >> 6, blk = blockIdx.x, G = gridDim.x;
    unsigned char* ws = a.ws;
    if (blk < 96) {
        LAS float* sc = (LAS float*)lds;
        LAS float* red = (LAS float*)(lds + 49152);
        for (int i = tid; i < 12 * 1024; i += 512) { const int r = i >> 10, k = i & 1023; const float c = r < 4 ? a.in[7][r * 1024 + k] : a.in[8][(r - 4) * 1024 + k]; sc[k * 12 + r] = c * sigmoidf_(c); }
        __syncthreads();
        float acc[12];
#pragma unroll
        for (int r = 0; r < 12; ++r) acc[r] = 0.f;
        const float* wp = a.in[10] + (size_t)(wid * 128) * 6144 + blk * 64 + lane;
#pragma unroll 8
        for (int kk = 0; kk < 128; ++kk) { const float wv = wp[(size_t)kk * 6144]; const LAS f32x4* s = (const LAS f32x4*)(sc + (wid * 128 + kk) * 12);
            const f32x4 s0 = s[0], s1 = s[1], s2 = s[2];
            acc[0] += s0[0] * wv; acc[1] += s0[1] * wv; acc[2] += s0[2] * wv; acc[3] += s0[3] * wv; acc[4] += s1[0] * wv; acc[5] += s1[1] * wv;
            acc[6] += s1[2] * wv; acc[7] += s1[3] * wv; acc[8] += s2[0] * wv; acc[9] += s2[1] * wv; acc[10] += s2[2] * wv; acc[11] += s2[3] * wv; }
#pragma unroll
        for (int r = 0; r < 12; ++r) red[(wid * 12 + r) * 64 + lane] = acc[r];
        __syncthreads();
        float* mod = (float*)(ws + WS_MOD);
        for (int i = tid; i < 768; i += 512) { const int r = i >> 6, c = i & 63; float s = 0.f;
#pragma unroll
            for (int w = 0; w < 8; ++w) s += red[(w * 12 + r) * 64 + c];
            mod[r * 6144 + blk * 64 + c] = s + a.in[11][blk * 64 + c]; }
        __syncthreads();
    }
    {
        LAS float* scr = (LAS float*)(lds + wid * 16384);
        const int gw = blk * 8 + wid, NGW = G * 8;
        constexpr int I_IN = 16 * 112, I_O = 16 * 32, I_G = 16 * 88, I_D = 44 * 32, I_L = 4 * 48;
        constexpr int NITEMS = I_IN + I_O + 2 * I_G + I_D + I_L;
        for (int it = gw; it < NITEMS; it += NGW) {
            int r = it;
            if (r < I_IN) { tr_item(SrcPlain{a.in[12], INC, INC}, DstId{}, (bf16_t*)(ws + WS_WIN), 1024, (r / 112) * 64, (r % 112) * 32, scr, lane); continue; } r -= I_IN;
            if (r < I_O) { tr_item(SrcRot{a.in[27]}, DstId{}, (bf16_t*)(ws + WS_WO), 1024, (r / 32) * 64, (r % 32) * 32, scr, lane); continue; } r -= I_O;
            if (r < I_G) { tr_item(SrcPlain{a.in[29], DFF, DFF}, DstGU{0}, (bf16_t*)(ws + WS_WGU), 1024, (r / 88) * 64, (r % 88) * 32, scr, lane); continue; } r -= I_G;
            if (r < I_G) { tr_item(SrcPlain{a.in[30], DFF, DFF}, DstGU{128}, (bf16_t*)(ws + WS_WGU), 1024, (r / 88) * 64, (r % 88) * 32, scr, lane); continue; } r -= I_G;
            if (r < I_D) { tr_item(SrcPlain{a.in[31], 1024, 1024}, DstId{}, (bf16_t*)(ws + WS_WD), DFF, (r / 32) * 64, (r % 32) * 32, scr, lane); continue; } r -= I_D;
            tr_item(SrcLora{a.in[15], a.in[17], a.in[18]}, DstId{}, (bf16_t*)(ws + WS_WL), 256, (r / 48) * 64, (r % 48) * 32, scr, lane);
        }
    }
    {
        const int gt = blk * 512 + tid, NGT = G * 512;
        for (int gidx = gt; gidx < 2 * 1048576; gidx += NGT) {
            const int which = gidx >> 20, g8 = gidx & 1048575; const size_t e = (size_t)g8 * 8; const int b = (int)(e >> 20); const size_t rem = e & 1048575;
            const float* src = (which ? a.in[3] : a.in[2]) + e; const f32x4 v0 = *(const f32x4*)src, v1 = *(const f32x4*)(src + 4);
            u32x4 o; o.x = pk2(v0[0], v0[1]); o.y = pk2(v0[2], v0[3]); o.z = pk2(v1[0], v1[1]); o.w = pk2(v1[2], v1[3]);
            bf16_t* dst = (bf16_t*)(ws + (which ? WS_VS : WS_KS)) + (size_t)b * NKS * 512 + rem; *(u32x4*)dst = o;
        }
    }
}

__device__ __forceinline__ void norm_rows(const float* xp, const float* xs, const float* gvec, const float* mod, int sh_off, int sc_off, bf16_t* XN) {
    const int lane = threadIdx.x & 63, gw = blockIdx.x * 8 + (threadIdx.x >> 6), NGW = gridDim.x * 8;
    f32x4 nx[4];
    auto ldrow = [&](int m) { const float* xr = (m < MP ? xp + (size_t)m * DM : xs + (size_t)(m - MP) * DM);
#pragma unroll
        for (int j = 0; j < 4; ++j) nx[j] = *(const f32x4*)(xr + 4 * lane + 256 * j); };
    if (gw < MT) ldrow(gw);
    for (int m = gw; m < MT; m += NGW) {
        const float* mr = mod + (size_t)batch_of_row(m) * 6144;
        f32x4 v[4]; float s = 0.f;
#pragma unroll
        for (int j = 0; j < 4; ++j) { v[j] = nx[j]; s += (v[j][0] * v[j][0] + v[j][1] * v[j][1]) + (v[j][2] * v[j][2] + v[j][3] * v[j][3]); }
        if (m + NGW < MT) ldrow(m + NGW);
        const float rinv = rsqrtf(wave_sum(s) * (1.f / DM) + 1e-6f);
#pragma unroll
        for (int j = 0; j < 4; ++j) { const int c = 4 * lane + 256 * j; const f32x4 g = *(const f32x4*)(gvec + c), sc = *(const f32x4*)(mr + sc_off + c), sh = *(const f32x4*)(mr + sh_off + c);
            f32x4 o;
#pragma unroll
            for (int q = 0; q < 4; ++q) o[q] = v[j][q] * rinv * g[q] * (1.f + sc[q]) + sh[q];
            u32x2 w; w.x = pk2(o[0], o[1]); w.y = pk2(o[2], o[3]); *(u32x2*)(XN + (size_t)m * DM + c) = w; }
    }
}

__device__ __forceinline__ void phase3(const Args& a) {
    const int lane = threadIdx.x & 63, gw = blockIdx.x * 8 + (threadIdx.x >> 6), NGW = gridDim.x * 8;
    unsigned char* ws = a.ws;
    bf16_t* PR = (bf16_t*)(ws + WS_PR); bf16_t* PF = (bf16_t*)(ws + WS_PF); bf16_t* A2 = (bf16_t*)(ws + WS_A2);
    const float* mu = a.in[13];
    struct P3Regs { u32x2 pw, qw; u32x4 q, k, v; bf16_t fl; };
    P3Regs nx;
    auto ldrow = [&](int m) { const bf16_t* pr = PR + (size_t)m * RC; const bf16_t* pf = PF + (size_t)m * RC; const int c = 1536 + 4 * lane;
        nx.pw = *(const u32x2*)(pr + c); nx.qw = *(const u32x2*)(PR + (size_t)(m > 0 ? m - 1 : 0) * RC + c);
        nx.q = *(const u32x4*)(pf + 8 * lane); nx.k = *(const u32x4*)(pf + 512 + 8 * lane); nx.v = *(const u32x4*)(pf + 1024 + 8 * lane); nx.fl = pf[1536 + (lane & 7)]; };
    if (gw < MT) ldrow(gw);
    for (int m = gw; m < MT; m += NGW) {
        const bool samp = m >= MP; const int ml = samp ? m - MP : m; const int b = samp ? (ml >> 6) : (ml >> 13); const int t = samp ? (ml & 63) : (ml & 8191);
        const bf16_t* pr = PR + (size_t)m * RC; bf16_t* pf = PF + (size_t)m * RC;
        const P3Regs cu = nx;
        if (m + NGW < MT) ldrow(m + NGW);
        {
            const int c = 1536 + 4 * lane; const u32x2 pw = cu.pw; float p[4] = {bflo(pw.x), bfhi(pw.x), bflo(pw.y), bfhi(pw.y)}; float pp[4];
            if (t > 0) { const u32x2 qw = cu.qw; pp[0] = bflo(qw.x); pp[1] = bfhi(qw.x); pp[2] = bflo(qw.y); pp[3] = bfhi(qw.y); }
            else if (samp) { const f32x4 q = *(const f32x4*)(a.in[6] + (size_t)b * RC + c); pp[0] = q[0]; pp[1] = q[1]; pp[2] = q[2]; pp[3] = q[3]; }
            else { pp[0] = pp[1] = pp[2] = pp[3] = 0.f; }
            const f32x4 mv = *(const f32x4*)(mu + c); float z[4];
#pragma unroll
            for (int j = 0; j < 4; ++j) { const float zz = p[j] + (pp[j] - p[j]) * mv[j]; z[j] = lane < 16 ? tanhf(zz) : (lane < 32 ? zz : sigmoidf_(zz)); }
            u32x2 w; w.x = pk2(z[0], z[1]); w.y = pk2(z[2], z[3]); *(u32x2*)(A2 + (size_t)m * 256 + 4 * lane) = w;
        }
        {
            float q[8]; unpack8(cu.q, q); float ss = 0.f;
#pragma unroll
            for (int j = 0; j < 8; ++j) ss += q[j] * q[j];
            const float rinv = rsqrtf(sum8(ss) * (1.f / 64.f) + 1e-6f) * QSCALE; const float* g = a.in[24] + ((8 * lane) & 63);
#pragma unroll
            for (int j = 0; j < 8; ++j) q[j] = q[j] * rinv * g[j];
            *(u32x4*)(pf + 8 * lane) = pack8(q);
        }
        {
            float k[8]; unpack8(cu.k, k); float ss = 0.f;
#pragma unroll
            for (int j = 0; j < 8; ++j) ss += k[j] * k[j];
            const float rinv = rsqrtf(sum8(ss) * (1.f / 64.f) + 1e-6f); const float* g = a.in[25] + ((8 * lane) & 63);
#pragma unroll
            for (int j = 0; j < 8; ++j) k[j] = k[j] * rinv * g[j];
            const u32x4 kb = pack8(k); *(u32x4*)(pf + 512 + 8 * lane) = kb;
            float* ko = a.out + (samp ? O_KS : O_KP) + (size_t)ml * 512 + 8 * lane;
            *(f32x4*)ko = (f32x4){k[0], k[1], k[2], k[3]}; *(f32x4*)(ko + 4) = (f32x4){k[4], k[5], k[6], k[7]};
            if (samp) *(u32x4*)((bf16_t*)(ws + WS_KS) + ((size_t)b * NKS + PAST + t) * 512 + 8 * lane) = kb;
        }
        {
            const u32x4 vb = cu.v; float v[8]; unpack8(vb, v);
            float* vo = a.out + (samp ? O_VS : O_VP) + (size_t)ml * 512 + 8 * lane;
            *(f32x4*)vo = (f32x4){v[0], v[1], v[2], v[3]}; *(f32x4*)(vo + 4) = (f32x4){v[4], v[5], v[6], v[7]};
            if (samp) *(u32x4*)((bf16_t*)(ws + WS_VS) + ((size_t)b * NKS + PAST + t) * 512 + 8 * lane) = vb;
        }
        if (lane < 8) { const float x = bf1(cu.fl) + a.in[26][lane]; const float lf = fminf(x, 0.f) - log1pf(__expf(-fabsf(x)));
            a.out[(samp ? O_LFS : O_LFP) + (size_t)ml * 8 + lane] = lf; }
        if (t == (samp ? TS - 1 : TP - 1)) { float* so = a.out + (samp ? O_SHS : O_SHP) + (size_t)b * RC;
            for (int c = lane; c < RC; c += 64) so[c] = bf1(pr[c]); }
    }
}

__device__ __forceinline__ void cumsum_block(LAS unsigned char* lds, const float* srcA, int nA, const float* srcB, int ntot, int tpt, float* dst  ) {
    const int tid = threadIdx.x, lane = tid & 63, wid = tid >> 6;
    LAS double* part = (LAS double*)lds;
    const int t0 = tid * tpt; const bool act = t0 < ntot;
    float s[8];
#pragma unroll
    for (int h = 0; h < 8; ++h) s[h] = 0.f;
    const float* pbase = t0 < nA ? srcA + (size_t)t0 * 8 : srcB + (size_t)(t0 - nA) * 8;
    if (act) for (int i0 = 0; i0 < tpt; i0 += 8) { f32x4 va[8], vb[8];
#pragma unroll
        for (int j = 0; j < 8; ++j) { va[j] = *(const f32x4*)(pbase + (size_t)(i0 + j) * 8); vb[j] = *(const f32x4*)(pbase + (size_t)(i0 + j) * 8 + 4); }
#pragma unroll
        for (int j = 0; j < 8; ++j) { s[0] += va[j][0]; s[1] += va[j][1]; s[2] += va[j][2]; s[3] += va[j][3]; s[4] += vb[j][0]; s[5] += vb[j][1]; s[6] += vb[j][2]; s[7] += vb[j][3]; } }
#pragma unroll
    for (int h = 0; h < 8; ++h) part[h * 512 + tid] = (double)s[h];
    __syncthreads();
    {
        double v[8]; double run = 0.0;
#pragma unroll
        for (int i = 0; i < 8; ++i) { v[i] = part[wid * 512 + lane * 8 + i]; run += v[i]; }
        double incl = run;
#pragma unroll
        for (int o = 1; o < 64; o <<= 1) { const double y = __shfl_up(incl, o); if (lane >= o) incl += y; }
        double ex = incl - run;
#pragma unroll
        for (int i = 0; i < 8; ++i) { const double tmp = v[i]; part[wid * 512 + lane * 8 + i] = ex; ex += tmp; }
    }
    __syncthreads();
    if (act) { double r[8];
#pragma unroll
        for (int h = 0; h < 8; ++h) r[h] = part[h * 512 + tid];
        for (int i0 = 0; i0 < tpt; i0 += 8) { f32x4 va[8], vb[8];
#pragma unroll
            for (int j = 0; j < 8; ++j) { va[j] = *(const f32x4*)(pbase + (size_t)(i0 + j) * 8); vb[j] = *(const f32x4*)(pbase + (size_t)(i0 + j) * 8 + 4); }
#pragma unroll
            for (int j = 0; j < 8; ++j) { const int t = t0 + i0 + j;
                r[0] += va[j][0]; r[1] += va[j][1]; r[2] += va[j][2]; r[3] += va[j][3]; r[4] += vb[j][0]; r[5] += vb[j][1]; r[6] += vb[j][2]; r[7] += vb[j][3];
#pragma unroll
                for (int h = 0; h < 8; ++h) dst[(size_t)h * ntot + t] = (float)(r[h] * (double)LOG2E); } } }
    __syncthreads();
}

constexpr int CL = 64, NCH = TP / CL, SA_ITEMS = 32 * NCH + 64;
constexpr int SA_G = 0, SA_NKM = 16384, SA_AKN = 33024, SA_ABT = 49664, SA_NT = 66048, SA_RT = 75264, SA_BQ = 84480, SA_KQ = 93696, SA_BHK = 102912, SA_KH = 112128,
              SA_ABRT = 121344, SA_AKRT = 130560, SA_GL = 139776, SA_TOT = 140032, SA_Z = SA_BQ, SA_NP = SA_KQ, SA_OUT = 0;
__device__ __forceinline__ f32x4 mm_tile(const LAS unsigned char* X, const LAS unsigned char* Y, int tm, int tn, int lane) {
    f32x4 acc = {0.f, 0.f, 0.f, 0.f};
#pragma unroll
    for (int ks = 0; ks < 2; ++ks) {
        const bf16x8 xa = *(const LAS bf16x8*)(X + (16 * tm + (lane & 15)) * 144 + (32 * ks + 8 * (lane >> 4)) * 2);
        const bf16x8 yb = *(const LAS bf16x8*)(Y + (16 * tn + (lane & 15)) * 144 + (32 * ks + 8 * (lane >> 4)) * 2);
        acc = __builtin_amdgcn_mfma_f32_16x16x32_bf16(xa, yb, acc, 0, 0, 0);
    }
    return acc;
}
template <int u> __device__ __forceinline__ void sub_step(float (&acc)[64], const LAS float* A) {
    const float xu = acc[u];
    constexpr int G0 = (u + 1) / 4, NV = 16 - G0;
    f32x4 av[NV];
#pragma unroll
    for (int g = 0; g < NV; ++g) av[g] = *(const volatile LAS f32x4*)(A + u * 64 + 4 * (G0 + g));
#pragma unroll
    for (int g = 0; g < NV; ++g) {
        asm volatile("v_fmac_f32 %0, %4, %5\n\tv_fmac_f32 %1, %4, %6\n\tv_fmac_f32 %2, %4, %7\n\tv_fmac_f32 %3, %4, %8"
                     : "+v"(acc[4 * (G0 + g)]), "+v"(acc[4 * (G0 + g) + 1]), "+v"(acc[4 * (G0 + g) + 2]), "+v"(acc[4 * (G0 + g) + 3]) : "v"(xu), "v"(av[g][0]), "v"(av[g][1]), "v"(av[g][2]), "v"(av[g][3]));
    }
    __builtin_amdgcn_sched_barrier(0);
}
template <int t0, int n> struct SubSteps { static __device__ __forceinline__ void run(float (&x)[64], const LAS float* A) { sub_step<t0>(x, A); SubSteps<t0 + 1, n - 1>::run(x, A); } };
template <int t0> struct SubSteps<t0, 0> { static __device__ __forceinline__ void run(float (&)[64], const LAS float*) {} };
struct SaRegs { u32x4 pr, pk, qr, qk, av; f32x4 w0, w1; };
__device__ __forceinline__ void sa_load(const Args& a, int item, SaRegs& R) {
    const int tid = threadIdx.x; unsigned char* ws = a.ws;
    const bf16_t* PR = (const bf16_t*)(ws + WS_PR); const float* WD = (const float*)(ws + WS_WDEC); const bf16_t* AG = (const bf16_t*)(ws + WS_AG);
    const bool samp = item >= 32 * NCH; const int bh = samp ? item - 32 * NCH : item >> 7, c = samp ? 0 : item & 127, b = bh >> 3, h = bh & 7;
    const int row0 = samp ? MP + b * TS : b * TP + c * CL; const int tl = tid >> 3, cgp = tid & 7, c0 = h * 64 + 8 * cgp, m = row0 + tl;
    const bf16_t* p = PR + (size_t)m * RC + c0; const bf16_t* q = PR + (size_t)(m > 0 ? m - 1 : 0) * RC + c0;
    R.pr = *(const u32x4*)p; R.pk = *(const u32x4*)(p + 512); R.qr = *(const u32x4*)q; R.qk = *(const u32x4*)(q + 512);
    R.av = *(const u32x4*)(AG + (size_t)m * 1024 + c0); const float* wp = WD + (size_t)m * 512 + c0; R.w0 = *(const f32x4*)wp; R.w1 = *(const f32x4*)(wp + 4);
}
__device__ __forceinline__ void sa_item(const Args& a, LAS unsigned char* lds, int item, const SaRegs& R, int prev_item) {
    const int tid = threadIdx.x, lane = tid & 63, wid = __builtin_amdgcn_readfirstlane(tid >> 6);
    unsigned char* ws = a.ws;
    const bf16_t* PR = (const bf16_t*)(ws + WS_PR); const float* WD = (const float*)(ws + WS_WDEC); const bf16_t* AG = (const bf16_t*)(ws + WS_AG); float* RK = (float*)(ws + WS_RK);
    const bool samp = item >= 32 * NCH; const int bh = samp ? item - 32 * NCH : item >> 7, c = samp ? 0 : item & 127, b = bh >> 3, h = bh & 7;
    const int row0 = samp ? MP + b * TS : b * TP + c * CL;
    const float* shift0 = samp ? a.in[6] + (size_t)b * RC : nullptr;
    LAS float* G = (LAS float*)(lds + SA_G); LAS float* GL = (LAS float*)(lds + SA_GL); LAS float* TOT = (LAS float*)(lds + SA_TOT);
    const int tl = tid >> 3, cgp = tid & 7, c0 = h * 64 + 8 * cgp, m = row0 + tl;
    float zr[8], nk[8], bb[8], kp[8];
    {
        float pr[8], pk[8], qr[8], qk[8], av[8];
        unpack8(R.pr, pr); unpack8(R.pk, pk); unpack8(R.qr, qr); unpack8(R.qk, qk); unpack8(R.av, av);
        const f32x4 w0 = R.w0, w1 = R.w1;
        if (c == 0 && tl == 0) {
#pragma unroll
            for (int j = 0; j < 8; ++j) { qr[j] = shift0 ? shift0[c0 + j] : 0.f; qk[j] = shift0 ? shift0[512 + c0 + j] : 0.f; }
        }
        const f32x4* m4 = (const f32x4*)(a.in[13] + c0); const f32x4 x0 = m4[0], x1 = m4[1], y0 = m4[128], y1 = m4[129];
        const f32x4* k4p = (const f32x4*)(a.in[19] + c0); const f32x4* a4p = (const f32x4*)(a.in[20] + c0); const f32x4* r4p = (const f32x4*)(a.in[21] + c0);
        const f32x4 kk0 = k4p[0], kk1 = k4p[1], ka0 = a4p[0], ka1 = a4p[1], rk0 = r4p[0], rk1 = r4p[1];
        float mur[8], muk[8], kkw[8], kaw[8], rkw[8];
#pragma unroll
        for (int j = 0; j < 4; ++j) { mur[j] = x0[j]; mur[4 + j] = x1[j]; muk[j] = y0[j]; muk[4 + j] = y1[j]; kkw[j] = kk0[j]; kkw[4 + j] = kk1[j]; kaw[j] = ka0[j]; kaw[4 + j] = ka1[j]; rkw[j] = rk0[j]; rkw[4 + j] = rk1[j]; }
        float zk[8], kk[8]; float ss = 0.f;
#pragma unroll
        for (int j = 0; j < 8; ++j) { zr[j] = pr[j] + (qr[j] - pr[j]) * mur[j]; zk[j] = pk[j] + (qk[j] - pk[j]) * muk[j]; kk[j] = zk[j] * kkw[j]; ss += kk[j] * kk[j]; }
        const float inv = 1.0f / fmaxf(sqrtf(sum8(ss)), 1e-12f); float rk = 0.f;
#pragma unroll
        for (int j = 0; j < 8; ++j) { const float kn = kk[j] * inv; nk[j] = -kn; bb[j] = kn * av[j]; kp[j] = zk[j] * (1.f + (av[j] - 1.f) * kaw[j]); rk += zr[j] * kp[j] * rkw[j]; }
        rk = sum8(rk);
        if (cgp == 0) RK[(size_t)m * 8 + h] = rk;
        *(LAS f32x4*)(G + tl * 64 + 8 * cgp) = w0; *(LAS f32x4*)(G + tl * 64 + 8 * cgp + 4) = w1;
    }
    __syncthreads();
    {
        const int k = tid & 63, part = tid >> 6; float run = 1.f; float g8[8];
#pragma unroll
        for (int i = 0; i < 8; ++i) g8[i] = G[(8 * part + i) * 64 + k];
#pragma unroll
        for (int i = 0; i < 8; ++i) { run *= g8[i]; g8[i] = run; }
        TOT[part * 64 + k] = run;
        __syncthreads();
        float tt[8];
#pragma unroll
        for (int p2 = 0; p2 < 8; ++p2) tt[p2] = TOT[p2 * 64 + k];
        float pre = 1.f;
#pragma unroll
        for (int p2 = 0; p2 < 8; ++p2) pre *= (p2 < part) ? tt[p2] : 1.f;
#pragma unroll
        for (int i = 0; i < 8; ++i) G[(8 * part + i) * 64 + k] = g8[i] * pre;
        if (part == 7) GL[k] = run * pre;
    }
    __syncthreads();
    {
        float nt[8], rt[8], bq[8], kq[8], bh8[8], kh8[8];
        const f32x4 gA = *(const LAS f32x4*)(G + tl * 64 + 8 * cgp), gB = *(const LAS f32x4*)(G + tl * 64 + 8 * cgp + 4), lA = *(const LAS f32x4*)(GL + 8 * cgp), lB = *(const LAS f32x4*)(GL + 8 * cgp + 4);
        const int tlp = tl > 0 ? tl - 1 : 0; const f32x4 pA = *(const LAS f32x4*)(G + tlp * 64 + 8 * cgp), pB = *(const LAS f32x4*)(G + tlp * 64 + 8 * cgp + 4);
#pragma unroll
        for (int j = 0; j < 8; ++j) { const float g = j < 4 ? gA[j & 3] : gB[j & 3], gp = tl > 0 ? (j < 4 ? pA[j & 3] : pB[j & 3]) : 1.f, gl = j < 4 ? lA[j & 3] : lB[j & 3], ig = __builtin_amdgcn_rcpf(g);
            nt[j] = gp * nk[j]; rt[j] = g * zr[j]; bq[j] = bb[j] * ig; kq[j] = kp[j] * ig; bh8[j] = bq[j] * gl; kh8[j] = kq[j] * gl; }
        *(LAS u32x4*)(lds + SA_NT + tl * 144 + cgp * 16) = pack8(nt); *(LAS u32x4*)(lds + SA_RT + tl * 144 + cgp * 16) = pack8(rt);
        *(LAS u32x4*)(lds + SA_BQ + tl * 144 + cgp * 16) = pack8(bq); *(LAS u32x4*)(lds + SA_KQ + tl * 144 + cgp * 16) = pack8(kq);
        *(LAS u32x4*)(lds + SA_KH + tl * 144 + cgp * 16) = pack8(kh8);
#pragma unroll
        for (int j = 0; j < 8; ++j) { const int k = 8 * cgp + j;
            ((LAS float*)(lds + SA_NKM))[k * 65 + tl] = nt[j]; ((LAS bf16_t*)(lds + SA_BHK))[k * 72 + tl] = (bf16_t)f2bf(bh8[j]); }
    }
    __syncthreads();
    {
        const int prod = wid >> 1, half = wid & 1;
        const LAS unsigned char* X = lds + ((prod & 1) ? SA_KQ : SA_BQ); const LAS unsigned char* Yb = lds + ((prod & 2) ? SA_RT : SA_NT);
        for (int ti = 0; ti < 8; ++ti) { const int tile = half * 8 + ti, tm = tile >> 2, tn = tile & 3;
            f32x4 acc = mm_tile(X, Yb, tm, tn, lane);
            const int s0 = 16 * tm + 4 * (lane >> 4), t = 16 * tn + (lane & 15);
#pragma unroll
            for (int r = 0; r < 4; ++r) { const int s = s0 + r; const bool keep = (prod & 2) ? (s <= t) : (s < t); if (!keep) acc[r] = 0.f; }
            if (prod == 0) { LAS float* o = (LAS float*)(lds + SA_ABT);
#pragma unroll
                for (int r = 0; r < 4; ++r) o[(s0 + r) * 64 + t] = acc[r]; }
            else if (prod == 1) { LAS float* o = (LAS float*)(lds + SA_AKN);
#pragma unroll
                for (int r = 0; r < 4; ++r) o[(s0 + r) * 65 + t] = acc[r]; }
            else { u32x2 w; w.x = pk2(acc[0], acc[1]); w.y = pk2(acc[2], acc[3]);
                *(LAS u32x2*)(lds + (prod == 2 ? SA_ABRT : SA_AKRT) + t * 144 + s0 * 2) = w; }
        }
    }
    if (prev_item >= 0) asm volatile("s_waitcnt vmcnt(0)" ::: "memory");
    __syncthreads();
    if (prev_item >= 0 && tid == 0) __hip_atomic_store((unsigned*)(ws + WS_CTL) + 1024 + prev_item, 1u, __ATOMIC_RELAXED, __HIP_MEMORY_SCOPE_AGENT);
    if (wid < 2) {
        const LAS float* rhs = (const LAS float*)(lds + (wid == 0 ? SA_AKN : SA_NKM)) + lane * 65; const LAS float* At = (const LAS float*)(lds + SA_ABT);
        float x[64];
#pragma unroll
        for (int t = 0; t < 64; ++t) x[t] = rhs[t];
        SubSteps<0, 63>::run(x, At);
        LAS unsigned char* o = lds + (wid == 0 ? SA_Z : SA_NP) + lane * 144;
#pragma unroll
        for (int g8 = 0; g8 < 8; ++g8) { u32x4 w; w.x = pk2(x[8 * g8], x[8 * g8 + 1]); w.y = pk2(x[8 * g8 + 2], x[8 * g8 + 3]); w.z = pk2(x[8 * g8 + 4], x[8 * g8 + 5]); w.w = pk2(x[8 * g8 + 6], x[8 * g8 + 7]); *(LAS u32x4*)(o + g8 * 16) = w; }
    }
    __syncthreads();
    {
        const int prod = wid >> 1, half = wid & 1;
        const LAS unsigned char* X = lds + ((prod == 0 || prod == 3) ? SA_BHK : SA_ABRT); const LAS unsigned char* Yb = lds + ((prod < 2) ? SA_NP : SA_Z);
        LAS bf16_t* OUT = (LAS bf16_t*)(lds + SA_OUT);
        const int rbase = (prod == 0 || prod == 3) ? 64 : 0, cbase = (prod < 2) ? 0 : 64;
        for (int ti = 0; ti < 8; ++ti) { const int tile = half * 8 + ti, tm = tile >> 2, tn = tile & 3;
            f32x4 acc = mm_tile(X, Yb, tm, tn, lane);
            const int m0 = 16 * tm + 4 * (lane >> 4), n = 16 * tn + (lane & 15);
            const LAS bf16_t* ap = (const LAS bf16_t*)(lds + (prod == 1 ? SA_RT : prod == 2 ? SA_AKRT : SA_KH)) + (prod == 3 ? n * 72 + m0 : m0 * 72 + n);
            const int st = (prod == 3) ? 1 : 72;
            const bf16_t a0 = ap[0], a1 = ap[st], a2 = ap[2 * st], a3 = ap[3 * st]; const float gl = GL[n];
            float addv[4] = {bf1(a0), bf1(a1), bf1(a2), bf1(a3)};
            if (prod == 0) {
#pragma unroll
                for (int r = 0; r < 4; ++r) addv[r] = (m0 + r == n) ? gl : 0.f; }
#pragma unroll
            for (int r = 0; r < 4; ++r) OUT[(rbase + m0 + r) * 136 + cbase + n] = (bf16_t)f2bf(acc[r] + addv[r]); }
    }
    __syncthreads();
    {
        unsigned char* dst = (unsigned char*)(a.out + O_Y) + (size_t)item * 32768;
#pragma unroll
        for (int ps = 0; ps < 4; ++ps) { const int idx = ps * 512 + tid, row = idx >> 4, ch = idx & 15;
            const u32x4 v = *(const LAS u32x4*)(lds + SA_OUT + row * 272 + ch * 16); unsigned char* gp = dst + row * 256 + ch * 16;
            asm volatile("global_store_dwordx4 %0, %1, off sc1\n\ts_nop 1" :: "v"(gp), "v"(v) : "memory"); }
    }
    __syncthreads();
}

constexpr int SB_A = 0, SB_B0 = 17408, SB_B1 = 17408 + 34816;
__device__ __forceinline__ void sb_chain(const Args& a, LAS unsigned char* lds, int item0, int nch, int row0, int h, const float* S0, float* Sout, const float* shift0) {
    const int tid = threadIdx.x, lane = tid & 63, wid = __builtin_amdgcn_readfirstlane(tid >> 6);
    unsigned char* ws = a.ws;
    const bf16_t* PR = (const bf16_t*)(ws + WS_PR); float* Y = (float*)(ws + WS_Y);
    LAS bf16_t* AI = (LAS bf16_t*)(lds + SB_A);
    const int tl = tid >> 3, cgp = tid & 7, c0 = 1024 + h * 64 + 8 * cgp;
    const f32x4 mv0 = *(const f32x4*)(a.in[13] + c0), mv1 = *(const f32x4*)(a.in[13] + c0 + 4);
    struct ChunkRegs { u32x4 b[4], pv, qv; };
    ChunkRegs r0, r1, r2, r3;
    auto load_chunk = [&](int c, ChunkRegs& R) {
        const unsigned char* src = (const unsigned char*)(a.out + O_Y) + (size_t)(item0 + c) * 32768;
#pragma unroll
        for (int ps = 0; ps < 4; ++ps) R.b[ps] = *(const u32x4*)(src + (ps * 512 + tid) * 16);
        const int m = row0 + c * CL + tl; R.pv = *(const u32x4*)(PR + (size_t)m * RC + c0); R.qv = *(const u32x4*)(PR + (size_t)(m > 0 ? m - 1 : 0) * RC + c0); };
    auto store_chunk = [&](int c, const ChunkRegs& R) {
        LAS unsigned char* B = lds + ((c & 1) ? SB_B1 : SB_B0);
#pragma unroll
        for (int ps = 0; ps < 4; ++ps) { const int idx = ps * 512 + tid, row = idx >> 4, ch = idx & 15; *(LAS u32x4*)(B + row * 272 + ch * 16) = R.b[ps]; }
        float pv[8], qv[8]; unpack8(R.pv, pv); unpack8(R.qv, qv);
        if (c == 0 && tl == 0) {
#pragma unroll
            for (int j = 0; j < 8; ++j) qv[j] = shift0 ? shift0[c0 + j] : 0.f; }
        const float mu[8] = {mv0[0], mv0[1], mv0[2], mv0[3], mv1[0], mv1[1], mv1[2], mv1[3]};
#pragma unroll
        for (int j = 0; j < 8; ++j) AI[(8 * cgp + j) * 136 + 64 + tl] = (bf16_t)f2bf(pv[j] + (qv[j] - pv[j]) * mu[j]); };
    for (int e = tid; e < 4096; e += 512) AI[(e >> 6) * 136 + (e & 63)] = S0 ? (bf16_t)f2bf(S0[e]) : (bf16_t)0;
    unsigned* flags = (unsigned*)(ws + WS_CTL) + 1024 + item0;
    int ready = 0;
#define SB_WAIT_BATCH() do { const int hi_ = (ready + 16 < nch) ? ready + 16 : nch; \
        if (tid == 0) { for (;;) { unsigned v_ = 1u; for (int k_ = ready; k_ < hi_; ++k_) { const unsigned f_ = __hip_atomic_load(flags + k_, __ATOMIC_RELAXED, __HIP_MEMORY_SCOPE_AGENT); v_ = f_ < v_ ? f_ : v_; } \
                if (v_ != 0u) break; __builtin_amdgcn_s_sleep(8); } \
            __builtin_amdgcn_fence(__ATOMIC_ACQUIRE, "agent"); asm volatile("s_waitcnt vmcnt(0)" ::: "memory"); } \
        ready = hi_; } while (0)
    SB_WAIT_BATCH();
    __syncthreads();
    load_chunk(0, r0); store_chunk(0, r0);
    if (nch > 1) load_chunk(1, r1);
    if (nch > 2) load_chunk(2, r2);
    if (nch > 3) load_chunk(3, r3);
    if (nch > 4) load_chunk(4, r0);
    __syncthreads();
    const int tm = wid & 3, tn0 = 4 * (wid >> 2);
    f32x4 acc[4];
#define SB_STEP(c, RN) do { \
        const LAS unsigned char* B = lds + (((c) & 1) ? SB_B1 : SB_B0); \
        _Pragma("unroll") for (int q = 0; q < 4; ++q) acc[q] = (f32x4){0.f, 0.f, 0.f, 0.f}; \
        _Pragma("unroll") for (int ks = 0; ks < 4; ++ks) { \
            const bf16x8 xa = *(const LAS bf16x8*)(lds + SB_A + (16 * tm + (lane & 15)) * 272 + (32 * ks + 8 * (lane >> 4)) * 2); \
            _Pragma("unroll") for (int q = 0; q < 4; ++q) { const bf16x8 yb = *(const LAS bf16x8*)(B + (16 * (tn0 + q) + (lane & 15)) * 272 + (32 * ks + 8 * (lane >> 4)) * 2); \
                acc[q] = __builtin_amdgcn_mfma_f32_16x16x32_bf16(xa, yb, acc[q], 0, 0, 0); } } \
        const int i0 = 16 * tm + 4 * (lane >> 4); \
        if (wid < 4) { _Pragma("unroll") for (int q = 0; q < 4; ++q) { const int t = 16 * q + (lane & 15); *(f32x4*)(Y + (size_t)(row0 + (c) * CL + t) * 512 + h * 64 + i0) = acc[q]; } } \
        __syncthreads(); \
        if (wid >= 4) { \
            _Pragma("unroll") for (int q = 0; q < 4; ++q) { const int kq = 16 * q + (lane & 15); _Pragma("unroll") for (int r = 0; r < 4; ++r) AI[(i0 + r) * 136 + kq] = (bf16_t)f2bf(acc[q][r]); } \
            if ((c) == nch - 1) { _Pragma("unroll") for (int q = 0; q < 4; ++q) { const int kq = 16 * q + (lane & 15); _Pragma("unroll") for (int r = 0; r < 4; ++r) Sout[(size_t)(i0 + r) * 64 + kq] = acc[q][r]; } } } \
        if ((c) + 1 < nch) store_chunk((c) + 1, RN); \
        if ((c) + 5 < nch && (c) + 5 >= ready) SB_WAIT_BATCH(); \
        __syncthreads(); \
        if ((c) + 5 < nch) load_chunk((c) + 5, RN); } while (0)
    for (int c = 0; c < nch; c += 4) {
        SB_STEP(c, r1);
        if (c + 1 < nch) SB_STEP(c + 1, r2);
        if (c + 2 < nch) SB_STEP(c + 2, r3);
        if (c + 3 < nch) SB_STEP(c + 3, r0);
    }
#undef SB_STEP
#undef SB_WAIT_BATCH
}

constexpr int AT_K0 = 0, AT_K1 = 9216, AT_V0 = 18432, AT_V1 = 30720, AT_NB0 = 43008, AT_NB1 = 43264, AT_WSF = 43520, AT_CNT = 45568;
__device__ __forceinline__ void attn_unit(LAS unsigned char* lds, const bf16_t* Q, int ldq, const bf16_t* K, const bf16_t* V, int ldkv, const float* lc2,
                                          bf16_t* O, int ldo, int nq_valid, int qpos0, float U2x2, float T2) {
    const int tid = threadIdx.x, lane = tid & 63, r32 = lane & 31, hi = lane >> 5, wid = __builtin_amdgcn_readfirstlane(tid >> 6);
    const int jmax = (qpos0 + nq_valid - 1) >> 6, ntile = jmax + 1;
    LAS float* wsf = (LAS float*)(lds + AT_WSF) + wid * 64; LAS int* cnt = (LAS int*)(lds + AT_CNT);
    const float Lq0 = lc2[qpos0];
    bool drop = false;
    if (tid < ntile) { const int kend = 64 * tid + 63; if (kend <= qpos0) drop = (Lq0 - lc2[kend] + U2x2 < -T2); }
    { const unsigned long long bal = __ballot(drop); if (lane == 0) cnt[wid] = __popcll(bal); }
    __syncthreads();
    int tlo = 0;
#pragma unroll
    for (int w = 0; w < 8; ++w) tlo += cnt[w];
    const float Lref = lc2[64 * tlo];
    const bool active = 32 * wid < nq_valid;
    const int qp_lo = qpos0 + 32 * wid, qp_hi = qp_lo + 31, qpos = qp_lo + r32;
    const float Lqw = active ? lc2[qp_lo] - Lref : 0.f;
    bf16x8 qr[4];
    if (active) {
#pragma unroll
        for (int d0 = 0; d0 < 4; ++d0) qr[d0] = *(const bf16x8*)(Q + (size_t)(32 * wid + r32) * ldq + d0 * 16 + hi * 8);
    } else {
#pragma unroll
        for (int d0 = 0; d0 < 4; ++d0) qr[d0] = (bf16x8){0, 0, 0, 0, 0, 0, 0, 0};
    }
    float m_run = -1e30f, l_run = 0.f; f32x16 o0 = {}, o1 = {};
    const int srow = tid >> 3, sch = tid & 7;
    u32x4 kreg, vreg; float nbreg = 0.f;
    auto load_tile = [&](int j) {
        kreg = *(const u32x4*)(K + (size_t)(64 * j + srow) * ldkv + 8 * sch); vreg = *(const u32x4*)(V + (size_t)(64 * j + srow) * ldkv + 8 * sch);
        if (tid < 64) nbreg = Lref - lc2[64 * j + tid]; };
    auto store_tile = [&](int b) {
        *(LAS u32x4*)(lds + (b ? AT_K1 : AT_K0) + srow * 144 + sch * 16) = kreg; *(LAS u32x4*)(lds + (b ? AT_V1 : AT_V0) + srow * 192 + sch * 16) = vreg;
        if (tid < 64) ((LAS float*)(lds + (b ? AT_NB1 : AT_NB0)))[tid] = nbreg; };
    load_tile(jmax); store_tile(0);
    __syncthreads();
    int buf = 0;
    for (int j = jmax; j >= tlo; --j) {
        if (j > tlo) load_tile(j - 1);
        const LAS unsigned char* Kt = lds + (buf ? AT_K1 : AT_K0); const LAS unsigned char* Vt = lds + (buf ? AT_V1 : AT_V0); const LAS float* NB = (const LAS float*)(lds + (buf ? AT_NB1 : AT_NB0));
        bool need = active && (64 * j <= qp_hi);
        if (need && (64 * j + 63 < qp_lo)) need = (Lqw + NB[63] + U2x2 >= -T2);
        if (need) {
            f32x16 p0 = {}, p1 = {};
#pragma unroll
            for (int d0 = 0; d0 < 4; ++d0) { const bf16x8 a0 = *(const LAS bf16x8*)(Kt + r32 * 144 + d0 * 32 + hi * 16), a1 = *(const LAS bf16x8*)(Kt + (32 + r32) * 144 + d0 * 32 + hi * 16);
                p0 = __builtin_amdgcn_mfma_f32_32x32x16_bf16(a0, qr[d0], p0, 0, 0, 0); p1 = __builtin_amdgcn_mfma_f32_32x32x16_bf16(a1, qr[d0], p1, 0, 0, 0); }
#pragma unroll
            for (int aa = 0; aa < 4; ++aa) { const f32x4 n0 = *(const LAS f32x4*)(NB + 8 * aa + 4 * hi), n1 = *(const LAS f32x4*)(NB + 32 + 8 * aa + 4 * hi);
#pragma unroll
                for (int b = 0; b < 4; ++b) { p0[4 * aa + b] += n0[b]; p1[4 * aa + b] += n1[b]; } }
            if (64 * j + 63 > qp_lo) {
#pragma unroll
                for (int r = 0; r < 16; ++r) { const int key = 64 * j + (r & 3) + 8 * (r >> 2) + 4 * hi; if (key > qpos) p0[r] = -1e30f; if (key + 32 > qpos) p1[r] = -1e30f; }
            }
            float rm = fmaxf(p0[0], p1[0]);
#pragma unroll
            for (int r = 1; r < 16; ++r) rm = fmaxf(rm, fmaxf(p0[r], p1[r]));
            rm = fmaxf(rm, __shfl_xor(rm, 32));
            if (__any(rm > m_run)) {
                const float mn = fmaxf(m_run, rm), f = __builtin_amdgcn_exp2f(m_run - mn); l_run *= f; m_run = mn;
                if (hi == 0) wsf[r32] = f;
                asm volatile("s_waitcnt lgkmcnt(0)" ::: "memory");
#pragma unroll
                for (int aa = 0; aa < 4; ++aa) { const f32x4 f4 = *(const LAS f32x4*)(wsf + 8 * aa + 4 * hi);
#pragma unroll
                    for (int b = 0; b < 4; ++b) { o0[4 * aa + b] *= f4[b]; o1[4 * aa + b] *= f4[b]; } }
            }
            float ls = 0.f;
#pragma unroll
            for (int r = 0; r < 16; ++r) { p0[r] = __builtin_amdgcn_exp2f(p0[r] - m_run); p1[r] = __builtin_amdgcn_exp2f(p1[r] - m_run); ls += p0[r] + p1[r]; }
            l_run += ls;
            bf16x8 pa[4];
#pragma unroll
            for (int s = 0; s < 4; ++s) { u32x4 w;
                if (s < 2) { w.x = pk2(p0[8 * s + 0], p0[8 * s + 1]); w.y = pk2(p0[8 * s + 2], p0[8 * s + 3]); w.z = pk2(p0[8 * s + 4], p0[8 * s + 5]); w.w = pk2(p0[8 * s + 6], p0[8 * s + 7]); }
                else { const int s2 = s - 2; w.x = pk2(p1[8 * s2 + 0], p1[8 * s2 + 1]); w.y = pk2(p1[8 * s2 + 2], p1[8 * s2 + 3]); w.z = pk2(p1[8 * s2 + 4], p1[8 * s2 + 5]); w.w = pk2(p1[8 * s2 + 6], p1[8 * s2 + 7]); }
                pa[s] = __builtin_bit_cast(bf16x8, w); }
            const LAS unsigned char* vb = Vt + (4 * hi + ((lane & 15) >> 2)) * 192 + (16 * ((lane >> 4) & 1) + 4 * (lane & 3)) * 2;
#pragma unroll
            for (int s = 0; s < 4; ++s) { const int kvb = (s & 1) * 16 + (s >> 1) * 32;
#pragma unroll
                for (int dh = 0; dh < 2; ++dh) { const LAS unsigned char* p = vb + kvb * 192 + dh * 64;
                    const v4i16_t lo = __builtin_amdgcn_ds_read_tr16_b64_v4i16((LAS v4i16_t*)p), hi4 = __builtin_amdgcn_ds_read_tr16_b64_v4i16((LAS v4i16_t*)(p + 8 * 192));
                    const bf16x8 bv = (bf16x8){lo[0], lo[1], lo[2], lo[3], hi4[0], hi4[1], hi4[2], hi4[3]};
                    if (dh == 0) o0 = __builtin_amdgcn_mfma_f32_32x32x16_bf16(pa[s], bv, o0, 0, 0, 0); else o1 = __builtin_amdgcn_mfma_f32_32x32x16_bf16(pa[s], bv, o1, 0, 0, 0); } }
        }
        if (j > tlo) store_tile(buf ^ 1);
        __syncthreads();
        buf ^= 1;
    }
    if (active) {
        const float lt = l_run + __shfl_xor(l_run, 32);
        if (hi == 0) wsf[32 + r32] = 1.0f / lt;
        asm volatile("s_waitcnt lgkmcnt(0)" ::: "memory");
#pragma unroll
        for (int aa = 0; aa < 4; ++aa) { const f32x4 i4 = *(const LAS f32x4*)(wsf + 32 + 8 * aa + 4 * hi);
#pragma unroll
            for (int b = 0; b < 4; ++b) { const int q = 32 * wid + 8 * aa + 4 * hi + b; bf16_t* op = O + (size_t)q * ldo + r32;
                op[0] = (bf16_t)f2bf(o0[4 * aa + b] * i4[b]); op[32] = (bf16_t)f2bf(o1[4 * aa + b] * i4[b]); } }
    }
    __syncthreads();
}

__device__ __forceinline__ void phase5(const Args& a, LAS unsigned char* lds) {
    const int tid = threadIdx.x, lane = tid & 63;
    unsigned char* ws = a.ws;
    float gq = fabsf(a.in[24][lane]), gk = fabsf(a.in[25][lane]);
#pragma unroll
    for (int o = 1; o < 64; o <<= 1) { gq = fmaxf(gq, __shfl_xor(gq, o)); gk = fmaxf(gk, __shfl_xor(gk, o)); }
    const float U2x2 = 2.0f * 8.0f * gq * gk * LOG2E * 1.03f + 0.5f, T2 = 20.0f * LOG2E;
    unsigned* ctr = (unsigned*)(ws + WS_CTL) + 64; LAS unsigned* su = (LAS unsigned*)(lds + AT_CNT + 64);
    bf16_t* PF = (bf16_t*)(ws + WS_PF);
    for (;;) {
        if (tid == 0) *su = atomicAdd(ctr, 1u);
        __syncthreads();
        const unsigned u = *su;
        __syncthreads();
        if (u >= 1024u + 64u) break;
        if (u < 1024u) { const int bh = u >> 5, qb = u & 31, b = bh >> 3, h = bh & 7; bf16_t* base = PF + (size_t)(b * TP) * RC + h * 64;
            attn_unit(lds, base + (size_t)(256 * qb) * RC, RC, base + 512, base + 1024, RC, (const float*)(ws + WS_LCP) + (size_t)bh * TP, base + (size_t)(256 * qb) * RC, RC, 256, 256 * qb, U2x2, T2); }
        else { const int bh = u - 1024, b = bh >> 3, h = bh & 7; bf16_t* qb_ = PF + (size_t)(MP + b * TS) * RC + h * 64;
            attn_unit(lds, qb_, RC, (const bf16_t*)(ws + WS_KS) + (size_t)b * NKS * 512 + h * 64, (const bf16_t*)(ws + WS_VS) + (size_t)b * NKS * 512 + h * 64, 512,
                      (const float*)(ws + WS_LCS) + (size_t)bh * NKS, qb_, RC, TS, PAST, U2x2, T2); }
    }
}

__device__ __forceinline__ void phase6(const Args& a, const pg8::RowSet rs, int rank, int pool, int opq) {
    const int tidq = threadIdx.x + opq; const int lane = tidq & 63, gw = rank * 8 + (tidq >> 6), NGW = pool * 8;
    unsigned char* ws = a.ws;
    const bf16_t* PR = (const bf16_t*)(ws + WS_PR); bf16_t* PF = (bf16_t*)(ws + WS_PF); const bf16_t* AG = (const bf16_t*)(ws + WS_AG);
    const float* Y = (const float*)(ws + WS_Y); const float* RK = (const float*)(ws + WS_RK);
    const int c = 8 * lane, nr = rs.nrows();
    struct P6Regs { f32x4 y0, y1; u32x4 pv, qv, g; float rk; };
    P6Regs nx;
    auto ldrow = [&](int r) { const int m = rs.grow(r);
        nx.y0 = *(const f32x4*)(Y + (size_t)m * 512 + c); nx.y1 = *(const f32x4*)(Y + (size_t)m * 512 + c + 4);
        nx.pv = *(const u32x4*)(PR + (size_t)m * RC + 1024 + c); nx.qv = *(const u32x4*)(PR + (size_t)(m > 0 ? m - 1 : 0) * RC + 1024 + c);
        nx.g = *(const u32x4*)(AG + (size_t)m * 1024 + 512 + c); nx.rk = RK[(size_t)m * 8 + (lane >> 3)]; };
    if (gw < nr) ldrow(gw);
    for (int r = gw; r < nr; r += NGW) {
        const int m = rs.grow(r);
        const bool samp = m >= MP; const int ml = samp ? m - MP : m; const int b = samp ? (ml >> 6) : (ml >> 13); const int t = samp ? (ml & 63) : (ml & 8191);
        const P6Regs cu = nx;
        if (r + NGW < nr) ldrow(r + NGW);
        const f32x4 y0 = cu.y0, y1 = cu.y1;
        float y[8] = {y0[0], y0[1], y0[2], y0[3], y1[0], y1[1], y1[2], y1[3]}; float s = 0.f;
#pragma unroll
        for (int j = 0; j < 8; ++j) s += y[j];
        const float mean = sum8(s) * (1.f / 64.f); float q = 0.f;
#pragma unroll
        for (int j = 0; j < 8; ++j) { y[j] -= mean; q += y[j] * y[j]; }
        const float rstd = rsqrtf(sum8(q) * (1.f / 64.f) + 64e-5f);
        float pv[8], qv[8], g[8]; unpack8(cu.pv, pv);
        if (t > 0) unpack8(cu.qv, qv);
        else {
#pragma unroll
            for (int j = 0; j < 8; ++j) qv[j] = samp ? a.in[6][(size_t)b * RC + 1024 + c + j] : 0.f; }
        unpack8(cu.g, g);
        const float rk = cu.rk; float o[8];
#pragma unroll
        for (int j = 0; j < 8; ++j) { const float zv = pv[j] + (qv[j] - pv[j]) * a.in[13][1024 + c + j]; o[j] = (y[j] * rstd * a.in[22][c + j] + a.in[23][c + j] + rk * zv) * g[j]; }
        *(u32x4*)(PF + (size_t)m * RC + 512 + c) = pack8(o);
    }
}
__device__ __forceinline__ void norm2_rows(const Args& a, const pg8::RowSet rs, int rank, int pool, const float* X1b, bf16_t* H2b, const float* mod, int opq) {
    const int tidq = threadIdx.x + opq; const int lane = tidq & 63, gw = rank * 8 + (tidq >> 6), NGW = pool * 8, nr = rs.nrows();
    const float* gvec = a.in[28];
    f32x4 nx[4];
    auto ldrow = [&](int r) { const float* xr = X1b + (size_t)rs.grow(r) * DM;
#pragma unroll
        for (int j = 0; j < 4; ++j) nx[j] = *(const f32x4*)(xr + 4 * lane + 256 * j); };
    if (gw < nr) ldrow(gw);
    for (int r = gw; r < nr; r += NGW) {
        const int m = rs.grow(r); const size_t br = (size_t)rs.brow(r);
        const float* mr = mod + (size_t)batch_of_row(m) * 6144;
        f32x4 v[4]; float s = 0.f;
#pragma unroll
        for (int j = 0; j < 4; ++j) { v[j] = nx[j]; s += (v[j][0] * v[j][0] + v[j][1] * v[j][1]) + (v[j][2] * v[j][2] + v[j][3] * v[j][3]); }
        if (r + NGW < nr) ldrow(r + NGW);
        const float rinv = rsqrtf(wave_sum(s) * (1.f / DM) + 1e-6f);
#pragma unroll
        for (int j = 0; j < 4; ++j) { const int c = 4 * lane + 256 * j; const f32x4 g = *(const f32x4*)(gvec + c), sc = *(const f32x4*)(mr + 4096 + c), sh = *(const f32x4*)(mr + 3072 + c);
            f32x4 o;
#pragma unroll
            for (int q = 0; q < 4; ++q) o[q] = v[j][q] * rinv * g[q] * (1.f + sc[q]) + sh[q];
            u32x2 w; w.x = pk2(o[0], o[1]); w.y = pk2(o[2], o[3]); *(u32x2*)(H2b + br * DM + c) = w; }
    }
}

constexpr int NPHASE = 6;

__global__ void __launch_bounds__(512, 2) mk_fwd(Args a) {
    extern __shared__ __attribute__((aligned(16))) unsigned char lds_raw[];
    LAS unsigned char* lds = (LAS unsigned char*)lds_raw;
    cg::grid_group grid = cg::this_grid();
#define GRID_BAR() do { XcdBarrier xb_; xb_.bar = (unsigned*)(a.ws + WS_CTL) + 6000; xb_.x = xb_xcc_id(); xb_.st = (volatile LAS unsigned*)(lds + 147200); xcd_barrier(xb_, false); } while (0)
#define GRID_BAR_FIRST() do { XcdBarrier xb_; xb_.bar = (unsigned*)(a.ws + WS_CTL) + 6000; xb_.x = xb_xcc_id(); xb_.st = (volatile LAS unsigned*)(lds + 147200); xcd_barrier(xb_, true); } while (0)
    unsigned char* ws = a.ws;
    const int lo = a.ph_lo, hi = a.ph_hi, G = gridDim.x, blk = blockIdx.x;
#define IN(k) (lo <= (k) && (k) < hi)
#define SEAM(k) do { if (IN(k) && IN((k) + 1)) { if (lo < 0) grid.sync(); else if ((k) == lo) GRID_BAR_FIRST(); else GRID_BAR(); } } while (0)
    float* mod = (float*)(ws + WS_MOD);
    if (IN(0)) { for (int rep = 0; rep < REP_ROWS; ++rep) phase0(a, lds); } SEAM(0);
    if (IN(1)) { for (int rep = 0; rep < REP_ROWS; ++rep) norm_rows(a.in[0], a.in[1], a.in[9], mod, 0, 1024, (bf16_t*)(ws + WS_XN)); } SEAM(1);
    if (IN(2)) { pg8::Gemm g{(const bf16_t*)(ws + WS_XN), (const bf16_t*)(ws + WS_WIN), MT, NPAD, 1024, 1024}; pg8::StaticOrder S; S.init(MT, NPAD, G, blk);
        pg8::EpiProj E{(bf16_t*)(ws + WS_PR), (bf16_t*)(ws + WS_PF)}; pg8::gemm_phase<pg8::EpiProj, pg8::StaticOrder, true>(lds, g, S, E); } SEAM(2);
    if (IN(3)) { phase3(a); } SEAM(3);
    if (IN(4)) {
        {
            const int it = (G >= 12) ? blk - (G - 12) : -1;
            if (it >= 0) {
                const bool pr = it < 4; const int b = pr ? it : it - 4;
                const float* sA = pr ? a.out + O_LFP + (size_t)b * TP * 8 : a.in[4] + (size_t)b * PAST * 8;
                const float* sB = a.out + O_LFS + (size_t)b * TS * 8;
                float* dst = pr ? (float*)(ws + WS_LCP) + (size_t)b * 8 * TP : (float*)(ws + WS_LCS) + (size_t)b * 8 * NKS;
                cumsum_block(lds, sA, pr ? TP : PAST, sB, pr ? TP : NKS, pr ? 16 : 8, dst);
            }
        }
        pg8::Gemm g{(const bf16_t*)(ws + WS_A2), (const bf16_t*)(ws + WS_WL), MT, 1536, 256, 256}; pg8::StaticOrder S; S.init(MT, 1536, G, blk);
        pg8::EpiLora E{(float*)(ws + WS_WDEC), (bf16_t*)(ws + WS_AG), a.in[14], a.in[16]}; pg8::gemm_phase<pg8::EpiLora, pg8::StaticOrder, true>(lds, g, S, E); } SEAM(4);
    if (IN(5)) {
        unsigned* ctl = (unsigned*)(ws + WS_CTL);
        if (blk < 32) {
            const int bh = blk, b = bh >> 3;
            sb_chain(a, lds, bh * NCH, NCH, b * TP, bh & 7, nullptr, a.out + O_STP + (size_t)bh * 4096, nullptr);
        } else {
            const int NSA = G - 32;
#define SA_ITEM_OF(q) ((q) < 64 ? 32 * NCH + (q) : (((q) - 64) & 31) * NCH + (((q) - 64) >> 5))
            int prev = -1; SaRegs cur, nxt; if (blk - 32 < SA_ITEMS) sa_load(a, SA_ITEM_OF(blk - 32), cur);
            for (int q = blk - 32; q < SA_ITEMS; q += NSA) { if (q + NSA < SA_ITEMS) sa_load(a, SA_ITEM_OF(q + NSA), nxt); sa_item(a, lds, SA_ITEM_OF(q), cur, prev); prev = SA_ITEM_OF(q); cur = nxt; }
            if (prev >= 0) { asm volatile("s_waitcnt vmcnt(0)" ::: "memory"); __syncthreads();
                if (threadIdx.x == 0) __hip_atomic_store(ctl + 1024 + prev, 1u, __ATOMIC_RELAXED, __HIP_MEMORY_SCOPE_AGENT); }
#undef SA_ITEM_OF
            if (blk < 96) { const int bh = blk - 32, b = bh >> 3;
                sb_chain(a, lds, 32 * NCH + bh, 1, MP + b * TS, bh & 7, a.in[5] + (size_t)bh * 4096, a.out + O_STS + (size_t)bh * 4096, a.in[6] + (size_t)b * RC); }
        }
        phase5(a, lds);
        GRID_BAR();
        {
            const pg8::RowSet rs{1, 0}; const int pool = G, rank = blk; unsigned* bw = ctl + 808;
            float* X1b = a.out + O_Y; bf16_t* H2b = (bf16_t*)(ws + WS_XN); bf16_t* ACTb = (bf16_t*)(ws + WS_ACT);
            phase6(a, rs, rank, pool, 0);
            GRID_BAR();
            { pg8::Gemm g{(const bf16_t*)(ws + WS_PF), (const bf16_t*)(ws + WS_WO), MT, 1024, 1024, RC}; pg8::MapOrder S{rs, 4, pool, rank, 1};
              pg8::EpiResid E{a.in[0], a.in[1], nullptr, X1b, nullptr, mod + 2048}; pg8::gemm_phase<pg8::EpiResid, pg8::MapOrder, true>(lds, g, S, E); }
            GRID_BAR();
            norm2_rows(a, rs, rank, pool, X1b, H2b, mod, 0);
            GRID_BAR();
            { pg8::Gemm g{H2b, (const bf16_t*)(ws + WS_WGU), MT, 2 * DFF, 1024, 1024}; pg8::MapOrder S{rs, 22, pool, rank, 0};
              pg8::EpiSwiglu E{ACTb}; pg8::gemm_phase<pg8::EpiSwiglu, pg8::MapOrder, true>(lds, g, S, E); }
            GRID_BAR();
            { pg8::Gemm g{ACTb, (const bf16_t*)(ws + WS_WD), MT, 1024, DFF, DFF}; pg8::MapOrder S{rs, 4, pool, rank, 0};
              pg8::EpiResid E{X1b, X1b + (size_t)MP * DM, nullptr, X1b, nullptr, mod + 5120}; pg8::gemm_phase<pg8::EpiResid, pg8::MapOrder, true>(lds, g, S, E); }
        }
    }
#undef IN
#undef SEAM
}

#ifndef MK_N_LAUNCHES
#define MK_N_LAUNCHES 1
#endif
extern "C" void kernel_launch(void* const* d_in, const int* in_sizes, int n_in, void* d_out, int out_size, void* d_ws, size_t ws_size, hipStream_t stream) {
    static int grid = 0;
    if (grid == 0) {
        if (n_in != 32 || ws_size < WS_END) { fprintf(stderr, "kernel_launch: unexpected n_in %d / ws %zu\n", n_in, ws_size); grid = -1; return; }
        int dev = 0, cus = 0, per_cu = 0;
        hipGetDevice(&dev); hipDeviceGetAttribute(&cus, hipDeviceAttributeMultiprocessorCount, dev);
        hipFuncSetAttribute((const void*)mk_fwd, hipFuncAttributeMaxDynamicSharedMemorySize, LDS_BYTES);
        hipOccupancyMaxActiveBlocksPerMultiprocessor(&per_cu, (const void*)mk_fwd, 512, LDS_BYTES);
        (void)hipGetLastError();
        if (per_cu < 1) per_cu = 1;
        grid = cus;
        if (grid < 1) grid = 256;
    }
    if (grid < 0) return;
    hipMemsetAsync((char*)d_ws + WS_CTL, 0, 40960, stream);
    Args a{};
    for (int i = 0; i < 32; ++i) a.in[i] = (const float*)d_in[i];
    a.out = (float*)d_out; a.ws = (unsigned char*)d_ws;
    if (MK_N_LAUNCHES == 1) {
        a.ph_lo = 0; a.ph_hi = NPHASE; void* args[] = {&a};
        hipError_t e = hipLaunchCooperativeKernel((const void*)mk_fwd, dim3(grid), dim3(512), args, LDS_BYTES, stream);
        if (e != hipSuccess) fprintf(stderr, "cooperative launch failed: %s (grid %d)\n", hipGetErrorString(e), grid);
    } else {
        for (int p = 0; p < NPHASE; ++p) { a.ph_lo = p; a.ph_hi = p + 1; hipLaunchKernelGGL(mk_fwd, dim3(grid), dim3(512), LDS_BYTES, stream, a); }
    }
}
```

```cpp
#include <hip/hip_runtime.h>
#include <hip/hip_cooperative_groups.h>
#include <cstdint>
#include <cstdio>
namespace cg = cooperative_groups;

#define LAS __attribute__((address_space(3)))
typedef unsigned short bf16_t;
typedef short bf16x8 __attribute__((ext_vector_type(8)));
typedef float f32x4 __attribute__((ext_vector_type(4)));
typedef float f32x2 __attribute__((ext_vector_type(2)));
typedef float f32x16 __attribute__((ext_vector_type(16)));
typedef unsigned u32x4 __attribute__((ext_vector_type(4)));
typedef unsigned u32x2 __attribute__((ext_vector_type(2)));
typedef short v4i16_t __attribute__((ext_vector_type(4)));

#ifndef REP_GEMM
#define REP_GEMM 1
#endif
#ifndef REP_SCAN
#define REP_SCAN 1
#endif
#ifndef REP_ROWS
#define REP_ROWS 1
#endif
constexpr int DM = 1024, TP = 8192, BP = 4, BS = 8, TS = 64, PAST = 2048, NKS = PAST + TS;
constexpr int MP = BP * TP, MS = BS * TS, MT = MP + MS;
constexpr int RC = 1792, INC = 3336, NPAD = 3584, DFF = 2816;
constexpr float LOG2E = 1.4426950408889634f;
constexpr float QSCALE = 0.125f * LOG2E;
constexpr size_t O_Y = 0, O_STP = 34078720, O_SHP = 34209792, O_KP = 34216960, O_VP = 50994176, O_LFP = 67771392,
                 O_STS = 68033536, O_SHS = 68295680, O_KS = 68310016, O_VS = 68572160, O_LFS = 68834304;
constexpr size_t KiB = 1024, MiB = 1u << 20;
constexpr size_t WS_CTL = 0, WS_MOD = 1 * MiB, WS_RK = 2 * MiB, WS_LCP = 3 * MiB + 256 * KiB, WS_LCS = 4 * MiB + 512 * KiB;
constexpr size_t WS_WIN = 6 * MiB, WS_WO = 13 * MiB, WS_WGU = 15 * MiB, WS_WD = 26 * MiB, WS_WL = 31 * MiB + 512 * KiB;
constexpr size_t WS_XN = 33 * MiB, WS_PR = 98 * MiB, WS_A2 = 211 * MiB + 768 * KiB, WS_PF = 228 * MiB;
constexpr size_t WS_WDEC = 341 * MiB + 768 * KiB, WS_AG = 406 * MiB + 768 * KiB, WS_KS = 471 * MiB + 768 * KiB, WS_VS = 488 * MiB + 256 * KiB;
constexpr size_t WS_END = 509 * MiB + 768 * KiB;
constexpr size_t WS_Y = WS_XN, WS_X1 = WS_PR, WS_ACT = WS_PF;
constexpr size_t WS_ACTG = WS_KS, WS_H2G = WS_A2;
static_assert(WS_PR + (size_t)MT * RC * 2 == WS_A2 && WS_A2 + (size_t)MT * 256 * 2 == WS_PF && WS_PF + (size_t)MT * RC * 2 == WS_WDEC, "ws map");
static_assert(WS_WDEC + (size_t)MT * 512 * 4 == WS_AG && WS_AG + (size_t)MT * 1024 * 2 == WS_KS && WS_X1 + (size_t)MT * 1024 * 4 == WS_PF, "ws map");
static_assert(WS_ACT + (size_t)MT * DFF * 2 == WS_AG && WS_XN + (size_t)MT * 1024 * 2 == WS_PR, "ws map");
constexpr int LDS_BYTES = 147456;

__device__ __forceinline__ float bflo(unsigned u) { return __uint_as_float(u << 16); }
__device__ __forceinline__ float bfhi(unsigned u) { return __uint_as_float(u & 0xffff0000u); }
__device__ __forceinline__ float bf1(bf16_t b) { return __uint_as_float(((unsigned)b) << 16); }
__device__ __forceinline__ unsigned f2bf(float f) { unsigned u = __float_as_uint(f); return (u + 0x7fffu + ((u >> 16) & 1u)) >> 16; }
__device__ __forceinline__ unsigned pk2(float lo, float hi) { return f2bf(lo) | (f2bf(hi) << 16); }
__device__ __forceinline__ void unpack8(u32x4 u, float* f) { f[0] = bflo(u.x); f[1] = bfhi(u.x); f[2] = bflo(u.y); f[3] = bfhi(u.y); f[4] = bflo(u.z); f[5] = bfhi(u.z); f[6] = bflo(u.w); f[7] = bfhi(u.w); }
__device__ __forceinline__ u32x4 pack8(const float* f) { u32x4 o; o.x = pk2(f[0], f[1]); o.y = pk2(f[2], f[3]); o.z = pk2(f[4], f[5]); o.w = pk2(f[6], f[7]); return o; }
__device__ __forceinline__ float wave_sum(float v) {
#pragma unroll
    for (int o = 1; o < 64; o <<= 1) v += __shfl_xor(v, o);
    return v;
}
__device__ __forceinline__ float sum8(float v) { v += __shfl_xor(v, 1); v += __shfl_xor(v, 2); v += __shfl_xor(v, 4); return v; }
__device__ __forceinline__ float sigmoidf_(float x) { return 1.0f / (1.0f + __expf(-x)); }
template <int CTRL> __device__ __forceinline__ float dppf(float x) { return __builtin_bit_cast(float, __builtin_amdgcn_update_dpp(0, __builtin_bit_cast(int, x), CTRL, 0xf, 0xf, true)); }
__device__ __forceinline__ float allsum16(float v) {
    v += dppf<0xB1>(v); v += dppf<0x4E>(v); v += dppf<0x141>(v); v += dppf<0x140>(v); return v;
}
__device__ __forceinline__ int batch_of_row(int m) { return m < MP ? (m >> 13) : 4 + ((m - MP) >> 6); }


__device__ __forceinline__ void cbar(unsigned* ctr, unsigned target) {
    asm volatile("s_waitcnt vmcnt(0)" ::: "memory");
    __syncthreads();
    if (threadIdx.x == 0) {
        __builtin_amdgcn_fence(__ATOMIC_RELEASE, "agent");
        asm volatile("s_waitcnt vmcnt(0)" ::: "memory");
        __hip_atomic_fetch_add(ctr, 1u, __ATOMIC_RELAXED, __HIP_MEMORY_SCOPE_AGENT);
        while (__hip_atomic_load(ctr, __ATOMIC_RELAXED, __HIP_MEMORY_SCOPE_AGENT) < target) __builtin_amdgcn_s_sleep(2);
        __builtin_amdgcn_fence(__ATOMIC_ACQUIRE, "agent");
        asm volatile("s_waitcnt vmcnt(0)" ::: "memory");
    }
    __syncthreads();
}

#define XB_TMO      128
#define XB_XCNT(j)  (256  + 64 * (j))
#define XB_XSUB(j)  (1280 + 64 * (j))
#define XB_XGEN(j)  (2304 + 64 * (j))
#define XB_TOP      3328
#define XB_TOPGEN   3392
#define XCD_BAR_WORDS 3456
#define XB_SPIN_CAP (1u << 22)
__device__ __forceinline__ unsigned xb_ld(unsigned* p)              { return __hip_atomic_load(p, __ATOMIC_RELAXED, __HIP_MEMORY_SCOPE_AGENT); }
__device__ __forceinline__ unsigned xb_add(unsigned* p, unsigned v) { return __hip_atomic_fetch_add(p, v, __ATOMIC_RELAXED, __HIP_MEMORY_SCOPE_AGENT); }
__device__ __forceinline__ unsigned xb_xcc_id() { return (unsigned)__builtin_amdgcn_s_getreg((3 << 11) | 20) & 0xFu; }
#define XB_SPIN(cond, bar) do { unsigned _sp = 0; while (cond) { __builtin_amdgcn_s_sleep(1); \
    if ((++_sp & 255u) == 0u) { if (xb_ld(&(bar)[XB_TMO])) break; if (_sp > XB_SPIN_CAP) { atomicAdd(&(bar)[XB_TMO], 1u); break; } } } } while (0)
struct XcdBarrier { unsigned* bar; unsigned x; volatile LAS unsigned* st; };
__device__ __forceinline__ XcdBarrier xcd_barrier_post(unsigned* bar, volatile LAS unsigned* st) {
    XcdBarrier b; b.bar = bar; b.x = xb_xcc_id(); b.st = st;
    if (threadIdx.x == 0) (void)xb_add(&bar[XB_XCNT(b.x)], 1u);
    return b;
}
__device__ __forceinline__ void xcd_barrier_complete(unsigned* bar, unsigned x, unsigned& nloc, unsigned& nx) {
    const unsigned Gn = gridDim.x * gridDim.y * gridDim.z;
    unsigned sum, cnt, mine, sp = 0u;
    for (;;) {
        sum = 0u; cnt = 0u; mine = 0u;
#pragma unroll
        for (unsigned j = 0; j < 16; ++j) { const unsigned c = xb_ld(&bar[XB_XCNT(j)]); sum += c; cnt += (c > 0u) ? 1u : 0u; mine = (j == x) ? c : mine; }
        if (sum == Gn) break;
        __builtin_amdgcn_s_sleep(1);
        if ((++sp & 255u) == 0u) { if (xb_ld(&bar[XB_TMO])) break; if (sp > XB_SPIN_CAP) { atomicAdd(&bar[XB_TMO], 1u); break; } }
    }
    nloc = mine > 0u ? mine : 1u; nx = cnt > 0u ? cnt : 1u;
}
__device__ __forceinline__ void xcd_barrier(const XcdBarrier& b, bool first) {
    asm volatile("s_waitcnt vmcnt(0)" ::: "memory");
    __syncthreads();
    if (threadIdx.x == 0) {
        unsigned* bar = b.bar;
        __builtin_amdgcn_s_waitcnt(0);
        unsigned nloc = first ? 0u : b.st[0], nx = first ? 0u : b.st[1];
        if (first) (void)xb_add(&bar[XB_XCNT(b.x)], 1u);
        if (nloc == 0u) { xcd_barrier_complete(bar, b.x, nloc, nx); b.st[0] = nloc; b.st[1] = nx; }
        const unsigned old = xb_add(&bar[XB_XSUB(b.x)], 1u);
        const unsigned gen = old / nloc;
        if (old + 1u == (gen + 1u) * nloc) {
            __builtin_amdgcn_fence(__ATOMIC_RELEASE, "agent");
            asm volatile("s_waitcnt vmcnt(0)" ::: "memory");
            const unsigned og = xb_add(&bar[XB_TOP], 1u);
            const unsigned tg = og / nx;
            if (og + 1u == (tg + 1u) * nx) xb_add(&bar[XB_TOPGEN], 1u);
            else XB_SPIN(xb_ld(&bar[XB_TOPGEN]) == tg, bar);
            __builtin_amdgcn_fence(__ATOMIC_ACQUIRE, "agent");
            xb_add(&bar[XB_XGEN(b.x)], 1u);
            asm volatile("s_waitcnt vmcnt(0)" ::: "memory");
        } else {
            XB_SPIN(xb_ld(&bar[XB_XGEN(b.x)]) == gen, bar);
            __builtin_amdgcn_fence(__ATOMIC_ACQUIRE, "agent");
            asm volatile("s_waitcnt vmcnt(0)" ::: "memory");
        }
    }
    __syncthreads();
}

namespace pg8 {
constexpr int BM = 256, BK = 64, HALF = 128, HTB = HALF * BK * 2, STAGE_BYTES = 8 * HTB, NXCD = 8, WGM = 8;
__host__ __device__ __forceinline__ int lds_byte(int r, int c) { const int st = (r >> 4) * 2 + (c >> 5), rr = r & 15, cc = c & 31, ob = rr * 64 + cc * 2; return st * 1024 + (ob ^ (((ob >> 9) & 1) << 5)); }
__host__ __device__ __forceinline__ void stage_rc(int b, int& R, int& C) { const int st = b / 1024, sb = b % 1024, swz = sb ^ (((sb >> 9) & 1) << 5); R = (st >> 1) * 16 + swz / 64; C = (st & 1) * 32 + (swz % 64) / 2; }
__host__ __device__ __forceinline__ int perm32(int rho) { const int n = rho >> 4, i = rho & 15; return 8 * (i >> 2) + 4 * n + (i & 3); }
struct Unit { int pm, pn, pg, pb; };
struct Gemm { const bf16_t* A; const bf16_t* Bt; int M, N, K, lda; };
struct StaticOrder {
    int nM, nN, nwg, G, c;
    __device__ void init(int M, int N, int G_, int c_) { nM = M / BM; nN = N / BM; nwg = nM * nN; G = G_; c = c_; }
    __device__ bool next(int i, Unit& u) const {
        const long L = (long)i * G + c; if (L >= (long)nwg * REP_GEMM) return false;
        int wgid = (int)(L % nwg); { const int q = nwg / NXCD, r = nwg % NXCD, xcd = wgid % NXCD, off = wgid / NXCD; wgid = (xcd < r ? xcd * (q + 1) : r * (q + 1) + (xcd - r) * q) + off; }
        const int nig = WGM * nN, gid = wgid / nig, fm = gid * WGM, gsz = (nM - fm) < WGM ? (nM - fm) : WGM;
        u.pm = fm + ((wgid % nig) % gsz); u.pn = (wgid % nig) / gsz; u.pg = u.pm; u.pb = u.pm; return true;
    }
};

struct RowSet {
    int rest, g;
    __device__ __forceinline__ int ntiles() const { return MT / 256; }
    __device__ __forceinline__ int nrows() const { return MT; }
    __device__ __forceinline__ int gtile(int rt) const { return rt; }
    __device__ __forceinline__ int grow(int r) const { return r; }
    __device__ __forceinline__ int brow(int r) const { return r; }
};
struct MapOrder {
    RowSet rs; int nN, pool, rank, a_global;
    __device__ bool next(int i, Unit& u) const {
        const int L = i * pool + rank; if (L >= rs.ntiles() * nN) return false;
        const int rt = L / nN; u.pn = L % nN; u.pg = rs.gtile(rt); u.pb = u.pg; u.pm = a_global ? u.pg : u.pb; return true;
    }
};
__device__ __forceinline__ unsigned cvt_pk_bf16(float lo, float hi) { unsigned r; asm volatile("v_cvt_pk_bf16_f32 %0, %1, %2" : "=v"(r) : "v"(lo), "v"(hi)); return r; }

struct EpiProj {
    static constexpr bool PERM = true;
    bf16_t* PR; bf16_t* PF;
    __device__ __forceinline__ void operator()(const f32x4 (&acc)[2][2][4][2], const Unit& u, int wr, int wc, int fr, int fq) const {
        int colt = u.pn * BM; bf16_t* base = PR; if (colt >= RC) { base = PF; colt -= RC; }
        const int row0 = u.pm * BM + wr * 64 + fr, col0 = colt + wc * 32 + 8 * fq;
#pragma unroll
        for (int ai = 0; ai < 2; ++ai)
#pragma unroll
            for (int m = 0; m < 4; ++m) { bf16_t* rowp = base + (size_t)(row0 + ai * HALF + m * 16) * RC + col0;
#pragma unroll
                for (int bj = 0; bj < 2; ++bj) { const f32x4 v0 = acc[ai][bj][m][0], v1 = acc[ai][bj][m][1]; u32x4 w;
                    w.x = cvt_pk_bf16(v0[0], v0[1]); w.y = cvt_pk_bf16(v0[2], v0[3]); w.z = cvt_pk_bf16(v1[0], v1[1]); w.w = cvt_pk_bf16(v1[2], v1[3]);
                    *(u32x4*)(rowp + bj * HALF) = w; } }
    }
};
struct EpiLora {
    static constexpr bool PERM = false;
    float* Wdec; bf16_t* AG; const float* w0; const float* a0;
    __device__ __forceinline__ void operator()(const f32x4 (&acc)[2][2][4][2], const Unit& u, int wr, int wc, int fr, int fq) const {
        const int type = u.pn >> 1, cbase = (u.pn & 1) * BM + wc * 32 + 4 * fq, row0 = u.pm * BM + wr * 64 + fr;
#pragma unroll
        for (int bj = 0; bj < 2; ++bj)
#pragma unroll
            for (int n = 0; n < 2; ++n) { const int ch = cbase + bj * HALF + n * 16;
                f32x4 bias = (f32x4){0.f, 0.f, 0.f, 0.f};
                if (type == 0) bias = *(const f32x4*)(w0 + ch); else if (type == 1) bias = *(const f32x4*)(a0 + ch);
#pragma unroll
                for (int ai = 0; ai < 2; ++ai)
#pragma unroll
                    for (int m = 0; m < 4; ++m) { const size_t row = (size_t)(row0 + ai * HALF + m * 16); f32x4 v = acc[ai][bj][m][n] + bias;
                        if (type == 0) { f32x4 o;
#pragma unroll
                            for (int j = 0; j < 4; ++j) o[j] = __expf(-0.6065306597126334f * sigmoidf_(v[j]));
                            *(f32x4*)(Wdec + row * 512 + ch) = o; }
                        else { if (type == 1) {
#pragma unroll
                                for (int j = 0; j < 4; ++j) v[j] = sigmoidf_(v[j]); }
                            u32x2 w; w.x = cvt_pk_bf16(v[0], v[1]); w.y = cvt_pk_bf16(v[2], v[3]);
                            *(u32x2*)(AG + row * 1024 + (type == 2 ? 512 : 0) + ch) = w; } } }
    }
};
struct EpiResid {
    static constexpr bool PERM = false;
    const float* base_p; const float* base_s; const float* base_buf; float* out_final; float* out_buf; const float* gate;
    __device__ __forceinline__ void operator()(const f32x4 (&acc)[2][2][4][2], const Unit& u, int wr, int wc, int fr, int fq) const {
        const int col0 = u.pn * BM + wc * 32 + 4 * fq;
#pragma unroll
        for (int ai = 0; ai < 2; ++ai)
#pragma unroll
            for (int m = 0; m < 4; ++m) { const int rl = ai * HALF + wr * 64 + m * 16 + fr, row = u.pg * BM + rl, rowb = u.pb * BM + rl;
                const float* bp = (base_buf ? base_buf + (size_t)rowb * DM : (row < MP ? base_p + (size_t)row * DM : base_s + (size_t)(row - MP) * DM)) + col0;
                const float* gp = gate + (size_t)batch_of_row(row) * 6144 + col0; float* op = (out_final ? out_final + (size_t)row * DM : out_buf + (size_t)rowb * DM) + col0;
#pragma unroll
                for (int bj = 0; bj < 2; ++bj)
#pragma unroll
                    for (int n = 0; n < 2; ++n) { const int o = bj * HALF + n * 16; const f32x4 b = *(const f32x4*)(bp + o), g = *(const f32x4*)(gp + o);
                        *(f32x4*)(op + o) = b + g * acc[ai][bj][m][n]; } }
    }
};
struct EpiSwiglu {
    static constexpr bool PERM = true;
    bf16_t* ACT;
    __device__ __forceinline__ void operator()(const f32x4 (&acc)[2][2][4][2], const Unit& u, int wr, int wc, int fr, int fq) const {
        const int row0 = u.pb * BM + wr * 64 + fr, col0 = u.pn * HALF + wc * 32 + 8 * fq;
#pragma unroll
        for (int ai = 0; ai < 2; ++ai)
#pragma unroll
            for (int m = 0; m < 4; ++m) { float r[8];
#pragma unroll
                for (int n = 0; n < 2; ++n)
#pragma unroll
                    for (int j = 0; j < 4; ++j) { const float g = acc[ai][0][m][n][j], up = acc[ai][1][m][n][j]; r[n * 4 + j] = g * __builtin_amdgcn_rcpf(1.0f + __expf(-g)) * up; }
                u32x4 w; w.x = cvt_pk_bf16(r[0], r[1]); w.y = cvt_pk_bf16(r[2], r[3]); w.z = cvt_pk_bf16(r[4], r[5]); w.w = cvt_pk_bf16(r[6], r[7]);
                *(u32x4*)(ACT + (size_t)(row0 + ai * HALF + m * 16) * DFF + col0) = w; }
    }
};

template <class Epi, class Sched, bool ALIGN_EPI>
__device__ __forceinline__ void gemm_phase(LAS unsigned char* lds, const Gemm g, const Sched& S, const Epi& E, int opq = 0) {
    const int tid = threadIdx.x + opq, wid = __builtin_amdgcn_readfirstlane(tid >> 6), lane = tid & 63, wr = wid >> 2, wc = wid & 3, fr = lane & 15, fq = lane >> 4;
    const int K = g.K, nt = K / BK, lda = g.lda;
    unsigned voffA[2], voffB[2];
#pragma unroll
    for (int i = 0; i < 2; ++i) { int R, C; stage_rc(tid * 16 + i * 8192, R, C); const int Rb = Epi::PERM ? ((R & ~31) + perm32(R & 31)) : R;
        voffA[i] = (unsigned)(R * lda + C) * 2u; voffB[i] = (unsigned)(Rb * K + C) * 2u; }
    const size_t kstep = (size_t)(BK * 2);
    const size_t hstepA = (size_t)HALF * lda * 2, hstepB = (size_t)HALF * K * 2;
    const size_t tstepA = 2 * hstepA, tstepB = 2 * hstepB;
    const unsigned ldsw = (unsigned)wid * 1024u;
    const int aoff = lds_byte(wr * 64 + fr, fq * 8), boff = lds_byte(wc * 32 + fr, fq * 8);
#define PG8_SA(b, h) (((b) * 2 + (h)) * HTB)
#define PG8_SB(b, h) ((4 + (b) * 2 + (h)) * HTB)
#define PG8_STAGE(bufoff, gbase, voff) do { _Pragma("unroll") for (int _i = 0; _i < 2; ++_i) \
        __builtin_amdgcn_global_load_lds((const unsigned*)((const char*)(gbase) + (voff)[_i]), (LAS unsigned*)(lds + (bufoff) + ldsw + _i * 8192), 16, 0, 0); } while (0)
#define PG8_LDA(dst, b, h) do { _Pragma("unroll") for (int m = 0; m < 4; ++m) _Pragma("unroll") for (int k = 0; k < 2; ++k) dst[m][k] = *(const LAS bf16x8*)(lds + PG8_SA(b, h) + aoff + m * 2048 + k * 1024); } while (0)
#define PG8_LDB(dst, b, h) do { _Pragma("unroll") for (int n = 0; n < 2; ++n) _Pragma("unroll") for (int k = 0; k < 2; ++k) dst[n][k] = *(const LAS bf16x8*)(lds + PG8_SB(b, h) + boff + n * 2048 + k * 1024); } while (0)
#define PG8_MMA(ai, bj, At, Bt) do { __builtin_amdgcn_s_setprio(1); _Pragma("unroll") for (int m = 0; m < 4; ++m) _Pragma("unroll") for (int n = 0; n < 2; ++n) _Pragma("unroll") for (int k = 0; k < 2; ++k) \
        acc[ai][bj][m][n] = __builtin_amdgcn_mfma_f32_16x16x32_bf16(Bt[n][k], At[m][k], acc[ai][bj][m][n], 0, 0, 0); __builtin_amdgcn_s_setprio(0); } while (0)
#define PG8_WAIT_V(n) asm volatile("s_waitcnt vmcnt(" #n ")" ::: "memory")
#define PG8_WAIT_L(n) asm volatile("s_waitcnt lgkmcnt(" #n ")" ::: "memory")
#define PG8_BAR __builtin_amdgcn_s_barrier()
#define PG8_SCHED __builtin_amdgcn_sched_barrier(0)
    Unit cur, nxt; int ui = 0;
    if (!S.next(0, cur)) return;
    f32x4 acc[2][2][4][2];
#pragma unroll
    for (int a = 0; a < 2; ++a)
#pragma unroll
        for (int b = 0; b < 2; ++b)
#pragma unroll
            for (int m = 0; m < 4; ++m)
#pragma unroll
                for (int n = 0; n < 2; ++n) acc[a][b][m][n] = (f32x4){0.f, 0.f, 0.f, 0.f};
    bf16x8 At[4][2], B0[2][2], B1[2][2];
    const char* cA = (const char*)g.A + (size_t)cur.pm * tstepA; const char* cB = (const char*)g.Bt + (size_t)cur.pn * tstepB;
    PG8_STAGE(PG8_SB(0, 0), cB, voffB); PG8_STAGE(PG8_SB(0, 1), cB + hstepB, voffB); PG8_STAGE(PG8_SA(0, 0), cA, voffA); PG8_STAGE(PG8_SA(0, 1), cA + hstepA, voffA);
    if (wr == 1) PG8_BAR;
    PG8_WAIT_V(2); PG8_BAR;
    PG8_STAGE(PG8_SB(1, 0), cB + kstep, voffB); PG8_STAGE(PG8_SA(1, 0), cA + kstep, voffA); PG8_STAGE(PG8_SB(1, 1), cB + hstepB + kstep, voffB);
    PG8_WAIT_V(6); PG8_BAR;
    for (;;) {
        const bool has_next = S.next(ui + 1, nxt);
        const char* nA = has_next ? (const char*)g.A + (size_t)nxt.pm * tstepA : cA; const char* nB = has_next ? (const char*)g.Bt + (size_t)nxt.pn * tstepB : cB;
        for (int t = 0; t < nt; t += 2) {
            const bool last = (t == nt - 2);
            const char* a1 = cA + (size_t)(t + 1) * kstep;
            const char* a2 = last ? nA : cA + (size_t)(t + 2) * kstep; const char* b2 = last ? nB : cB + (size_t)(t + 2) * kstep;
            const char* a3 = a2 + kstep; const char* b3 = b2 + kstep;
            PG8_LDB(B0, 0, 0); PG8_LDB(B1, 0, 1); PG8_SCHED; PG8_LDA(At, 0, 0); PG8_STAGE(PG8_SA(1, 1), a1 + hstepA, voffA);
            PG8_WAIT_V(8); PG8_WAIT_L(0); PG8_BAR; PG8_MMA(0, 0, At, B0); PG8_MMA(0, 1, At, B1); PG8_BAR; PG8_SCHED;
            PG8_LDA(At, 0, 1); PG8_STAGE(PG8_SB(0, 0), b2, voffB); PG8_STAGE(PG8_SB(0, 1), b2 + hstepB, voffB); PG8_STAGE(PG8_SA(0, 0), a2, voffA);
            PG8_WAIT_V(8); PG8_WAIT_L(0); PG8_BAR; PG8_MMA(1, 0, At, B0); PG8_MMA(1, 1, At, B1); PG8_BAR; PG8_SCHED;
            PG8_LDB(B0, 1, 0); PG8_LDB(B1, 1, 1); PG8_SCHED; PG8_LDA(At, 1, 0); PG8_STAGE(PG8_SA(0, 1), a2 + hstepA, voffA);
            PG8_WAIT_V(8); PG8_WAIT_L(0); PG8_BAR; PG8_MMA(0, 0, At, B0); PG8_MMA(0, 1, At, B1); PG8_BAR; PG8_SCHED;
            PG8_LDA(At, 1, 1); PG8_STAGE(PG8_SB(1, 0), b3, voffB); PG8_STAGE(PG8_SB(1, 1), b3 + hstepB, voffB); PG8_STAGE(PG8_SA(1, 0), a3, voffA);
            PG8_WAIT_V(8); PG8_WAIT_L(0); PG8_BAR; PG8_MMA(1, 0, At, B0); PG8_MMA(1, 1, At, B1); PG8_BAR; PG8_SCHED;
        }
        if constexpr (ALIGN_EPI) { if (wr == 0) PG8_BAR; }
        E(acc, cur, wr, wc, fr, fq);
        if (!has_next) break;
#pragma unroll
        for (int a = 0; a < 2; ++a)
#pragma unroll
            for (int b = 0; b < 2; ++b)
#pragma unroll
                for (int m = 0; m < 4; ++m)
#pragma unroll
                    for (int n = 0; n < 2; ++n) acc[a][b][m][n] = (f32x4){0.f, 0.f, 0.f, 0.f};
        cur = nxt; cA = nA; cB = nB; ++ui;
        if constexpr (ALIGN_EPI) { if (wr == 1) PG8_BAR; }
    }
    PG8_WAIT_V(0);
    if constexpr (!ALIGN_EPI) { if (wr == 0) PG8_BAR; }
    PG8_BAR;
#undef PG8_SA
#undef PG8_SB
#undef PG8_STAGE
#undef PG8_LDA
#undef PG8_LDB
#undef PG8_MMA
#undef PG8_WAIT_V
#undef PG8_WAIT_L
#undef PG8_BAR
#undef PG8_SCHED
}
}

struct Args { const float* in[32]; float* out; unsigned char* ws; int ph_lo, ph_hi; };

struct SrcPlain { const float* W; int ld, nvalid; __device__ __forceinline__ float operator()(int k, int n) const { return n < nvalid ? W[(size_t)k * ld + n] : 0.f; } };
struct SrcRot { const float* W; __device__ __forceinline__ float operator()(int k, int n) const { return W[(size_t)((k + 512) & 1023) * 1024 + n]; } };
struct SrcLora { const float* wd; const float* wa; const float* wg;
    __device__ __forceinline__ float operator()(int k, int n) const {
        if (n < 512) return k < 64 ? wd[k * 512 + n] : 0.f;
        if (n < 1024) return (k >= 64 && k < 128) ? wa[(k - 64) * 512 + (n - 512)] : 0.f;
        return k >= 128 ? wg[(k - 128) * 512 + (n - 1024)] : 0.f; } };
struct DstId { __device__ __forceinline__ int operator()(int n) const { return n; } };
struct DstGU { int add; __device__ __forceinline__ int operator()(int n) const { return (n >> 7) * 256 + (n & 127) + add; } };
template <class SrcF, class DstF>
__device__ __forceinline__ void tr_item(const SrcF& src, const DstF& drow, bf16_t* WT, int ldt, int k0, int n0, LAS float* scr, int lane) {
#pragma unroll 8
    for (int i = 0; i < 32; ++i) { const int kk = 2 * i + (lane >> 5); scr[kk * 33 + (lane & 31)] = src(k0 + kk, n0 + (lane & 31)); }
    asm volatile("s_waitcnt lgkmcnt(0)" ::: "memory");
    const int c = lane & 7;
#pragma unroll
    for (int j = 0; j < 4; ++j) { const int n = (lane >> 3) + 8 * j; const LAS float* s = scr + (8 * c) * 33 + n;
        u32x4 o; o.x = pk2(s[0 * 33], s[1 * 33]); o.y = pk2(s[2 * 33], s[3 * 33]); o.z = pk2(s[4 * 33], s[5 * 33]); o.w = pk2(s[6 * 33], s[7 * 33]);
        *(u32x4*)(WT + (size_t)drow(n0 + n) * ldt + k0 + 8 * c) = o; }
    asm volatile("s_waitcnt lgkmcnt(0)" ::: "memory");
}

__device__ __forceinline__ void phase0(const Args& a, LAS unsigned char* lds) {
    const int tid = threadIdx.x, lane = tid & 63, wid = tid >> 6, blk = blockIdx.x, G = gridDim.x;
    unsigned char* ws = a.ws;
    if (blk < 96) {
        LAS float* sc = (LAS float*)lds;
        LAS float* red = (LAS float*)(lds + 49152);
        for (int i = tid; i < 12 * 1024; i += 512) { const int r = i >> 10, k = i & 1023; const float c = r < 4 ? a.in[7][r * 1024 + k] : a.in[8][(r - 4) * 1024 + k]; sc[k * 12 + r] = c * sigmoidf_(c); }
        __syncthreads();
        float acc[12];
#pragma unroll
        for (int r = 0; r < 12; ++r) acc[r] = 0.f;
        const float* wp = a.in[10] + (size_t)(wid * 128) * 6144 + blk * 64 + lane;
#pragma unroll 8
        for (int kk = 0; kk < 128; ++kk) { const float wv = wp[(size_t)kk * 6144]; const LAS f32x4* s = (const LAS f32x4*)(sc + (wid * 128 + kk) * 12);
            const f32x4 s0 = s[0], s1 = s[1], s2 = s[2];
            acc[0] += s0[0] * wv; acc[1] += s0[1] * wv; acc[2] += s0[2] * wv; acc[3] += s0[3] * wv; acc[4] += s1[0] * wv; acc[5] += s1[1] * wv;
            acc[6] += s1[2] * wv; acc[7] += s1[3] * wv; acc[8] += s2[0] * wv; acc[9] += s2[1] * wv; acc[10] += s2[2] * wv; acc[11] += s2[3] * wv; }
#pragma unroll
        for (int r = 0; r < 12; ++r) red[(wid * 12 + r) * 64 + lane] = acc[r];
        __syncthreads();
        float* mod = (float*)(ws + WS_MOD);
        for (int i = tid; i < 768; i += 512) { const int r = i >> 6, c = i & 63; float s = 0.f;
#pragma unroll
            for (int w = 0; w < 8; ++w) s += red[(w * 12 + r) * 64 + c];
            mod[r * 6144 + blk * 64 + c] = s + a.in[11][blk * 64 + c]; }
        __syncthreads();
    }
    {
        LAS float* scr = (LAS float*)(lds + wid * 16384);
        const int gw = blk * 8 + wid, NGW = G * 8;
        constexpr int I_IN = 16 * 112, I_O = 16 * 32, I_G = 16 * 88, I_D = 44 * 32, I_L = 4 * 48;
        constexpr int NITEMS = I_IN + I_O + 2 * I_G + I_D + I_L;
        for (int it = gw; it < NITEMS; it += NGW) {
            int r = it;
            if (r < I_IN) { tr_item(SrcPlain{a.in[12], INC, INC}, DstId{}, (bf16_t*)(ws + WS_WIN), 1024, (r / 112) * 64, (r % 112) * 32, scr, lane); continue; } r -= I_IN;
            if (r < I_O) { tr_item(SrcRot{a.in[27]}, DstId{}, (bf16_t*)(ws + WS_WO), 1024, (r / 32) * 64, (r % 32) * 32, scr, lane); continue; } r -= I_O;
            if (r < I_G) { tr_item(SrcPlain{a.in[29], DFF, DFF}, DstGU{0}, (bf16_t*)(ws + WS_WGU), 1024, (r / 88) * 64, (r % 88) * 32, scr, lane); continue; } r -= I_G;
            if (r < I_G) { tr_item(SrcPlain{a.in[30], DFF, DFF}, DstGU{128}, (bf16_t*)(ws + WS_WGU), 1024, (r / 88) * 64, (r % 88) * 32, scr, lane); continue; } r -= I_G;
            if (r < I_D) { tr_item(SrcPlain{a.in[31], 1024, 1024}, DstId{}, (bf16_t*)(ws + WS_WD), DFF, (r / 32) * 64, (r % 32) * 32, scr, lane); continue; } r -= I_D;
            tr_item(SrcLora{a.in[15], a.in[17], a.in[18]}, DstId{}, (bf16_t*)(ws + WS_WL), 256, (r / 48) * 64, (r % 48) * 32, scr, lane);
        }
    }
    {
        const int gt = blk * 512 + tid, NGT = G * 512;
        for (int gidx = gt; gidx < 2 * 1048576; gidx += NGT) {
            const int which = gidx >> 20, g8 = gidx & 1048575; const size_t e = (size_t)g8 * 8; const int b = (int)(e >> 20); const size_t rem = e & 1048575;
            const float* src = (which ? a.in[3] : a.in[2]) + e; const f32x4 v0 = *(const f32x4*)src, v1 = *(const f32x4*)(src + 4);
            u32x4 o; o.x = pk2(v0[0], v0[1]); o.y = pk2(v0[2], v0[3]); o.z = pk2(v1[0], v1[1]); o.w = pk2(v1[2], v1[3]);
            bf16_t* dst = (bf16_t*)(ws + (which ? WS_VS : WS_KS)) + (size_t)b * NKS * 512 + rem; *(u32x4*)dst = o;
        }
    }
}

__device__ __forceinline__ void norm_rows(const float* xp, const float* xs, const float* gvec, const float* mod, int sh_off, int sc_off, bf16_t* XN) {
    const int lane = threadIdx.x & 63, gw = blockIdx.x * 8 + (threadIdx.x >> 6), NGW = gridDim.x * 8;
    f32x4 nx[4];
    auto ldrow = [&](int m) { const float* xr = (m < MP ? xp + (size_t)m * DM : xs + (size_t)(m - MP) * DM);
#pragma unroll
        for (int j = 0; j < 4; ++j) nx[j] = *(const f32x4*)(xr + 4 * lane + 256 * j); };
    if (gw < MT) ldrow(gw);
    for (int m = gw; m < MT; m += NGW) {
        const float* mr = mod + (size_t)batch_of_row(m) * 6144;
        f32x4 v[4]; float s = 0.f;
#pragma unroll
        for (int j = 0; j < 4; ++j) { v[j] = nx[j]; s += (v[j][0] * v[j][0] + v[j][1] * v[j][1]) + (v[j][2] * v[j][2] + v[j][3] * v[j][3]); }
        if (m + NGW < MT) ldrow(m + NGW);
        const float rinv = rsqrtf(wave_sum(s) * (1.f / DM) + 1e-6f);
#pragma unroll
        for (int j = 0; j < 4; ++j) { const int c = 4 * lane + 256 * j; const f32x4 g = *(const f32x4*)(gvec + c), sc = *(const f32x4*)(mr + sc_off + c), sh = *(const f32x4*)(mr + sh_off + c);
            f32x4 o;
#pragma unroll
            for (int q = 0; q < 4; ++q) o[q] = v[j][q] * rinv * g[q] * (1.f + sc[q]) + sh[q];
            u32x2 w; w.x = pk2(o[0], o[1]); w.y = pk2(o[2], o[3]); *(u32x2*)(XN + (size_t)m * DM + c) = w; }
    }
}

__device__ __forceinline__ void phase3(const Args& a) {
    const int lane = threadIdx.x & 63, gw = blockIdx.x * 8 + (threadIdx.x >> 6), NGW = gridDim.x * 8;
    unsigned char* ws = a.ws;
    bf16_t* PR = (bf16_t*)(ws + WS_PR); bf16_t* PF = (bf16_t*)(ws + WS_PF); bf16_t* A2 = (bf16_t*)(ws + WS_A2);
    const float* mu = a.in[13];
    struct P3Regs { u32x2 pw, qw; u32x4 q, k, v; bf16_t fl; };
    P3Regs nx;
    auto ldrow = [&](int m) { const bf16_t* pr = PR + (size_t)m * RC; const bf16_t* pf = PF + (size_t)m * RC; const int c = 1536 + 4 * lane;
        nx.pw = *(const u32x2*)(pr + c); nx.qw = *(const u32x2*)(PR + (size_t)(m > 0 ? m - 1 : 0) * RC + c);
        nx.q = *(const u32x4*)(pf + 8 * lane); nx.k = *(const u32x4*)(pf + 512 + 8 * lane); nx.v = *(const u32x4*)(pf + 1024 + 8 * lane); nx.fl = pf[1536 + (lane & 7)]; };
    if (gw < MT) ldrow(gw);
    for (int m = gw; m < MT; m += NGW) {
        const bool samp = m >= MP; const int ml = samp ? m - MP : m; const int b = samp ? (ml >> 6) : (ml >> 13); const int t = samp ? (ml & 63) : (ml & 8191);
        const bf16_t* pr = PR + (size_t)m * RC; bf16_t* pf = PF + (size_t)m * RC;
        const P3Regs cu = nx;
        if (m + NGW < MT) ldrow(m + NGW);
        {
            const int c = 1536 + 4 * lane; const u32x2 pw = cu.pw; float p[4] = {bflo(pw.x), bfhi(pw.x), bflo(pw.y), bfhi(pw.y)}; float pp[4];
            if (t > 0) { const u32x2 qw = cu.qw; pp[0] = bflo(qw.x); pp[1] = bfhi(qw.x); pp[2] = bflo(qw.y); pp[3] = bfhi(qw.y); }
            else if (samp) { const f32x4 q = *(const f32x4*)(a.in[6] + (size_t)b * RC + c); pp[0] = q[0]; pp[1] = q[1]; pp[2] = q[2]; pp[3] = q[3]; }
            else { pp[0] = pp[1] = pp[2] = pp[3] = 0.f; }
            const f32x4 mv = *(const f32x4*)(mu + c); float z[4];
#pragma unroll
            for (int j = 0; j < 4; ++j) { const float zz = p[j] + (pp[j] - p[j]) * mv[j]; z[j] = lane < 16 ? tanhf(zz) : (lane < 32 ? zz : sigmoidf_(zz)); }
            u32x2 w; w.x = pk2(z[0], z[1]); w.y = pk2(z[2], z[3]); *(u32x2*)(A2 + (size_t)m * 256 + 4 * lane) = w;
        }
        {
            float q[8]; unpack8(cu.q, q); float ss = 0.f;
#pragma unroll
            for (int j = 0; j < 8; ++j) ss += q[j] * q[j];
            const float rinv = rsqrtf(sum8(ss) * (1.f / 64.f) + 1e-6f) * QSCALE; const float* g = a.in[24] + ((8 * lane) & 63);
#pragma unroll
            for (int j = 0; j < 8; ++j) q[j] = q[j] * rinv * g[j];
            *(u32x4*)(pf + 8 * lane) = pack8(q);
        }
        {
            float k[8]; unpack8(cu.k, k); float ss = 0.f;
#pragma unroll
            for (int j = 0; j < 8; ++j) ss += k[j] * k[j];
            const float rinv = rsqrtf(sum8(ss) * (1.f / 64.f) + 1e-6f); const float* g = a.in[25] + ((8 * lane) & 63);
#pragma unroll
            for (int j = 0; j < 8; ++j) k[j] = k[j] * rinv * g[j];
            const u32x4 kb = pack8(k); *(u32x4*)(pf + 512 + 8 * lane) = kb;
            float* ko = a.out + (samp ? O_KS : O_KP) + (size_t)ml * 512 + 8 * lane;
            *(f32x4*)ko = (f32x4){k[0], k[1], k[2], k[3]}; *(f32x4*)(ko + 4) = (f32x4){k[4], k[5], k[6], k[7]};
            if (samp) *(u32x4*)((bf16_t*)(ws + WS_KS) + ((size_t)b * NKS + PAST + t) * 512 + 8 * lane) = kb;
        }
        {
            const u32x4 vb = cu.v; float v[8]; unpack8(vb, v);
            float* vo = a.out + (samp ? O_VS : O_VP) + (size_t)ml * 512 + 8 * lane;
            *(f32x4*)vo = (f32x4){v[0], v[1], v[2], v[3]}; *(f32x4*)(vo + 4) = (f32x4){v[4], v[5], v[6], v[7]};
            if (samp) *(u32x4*)((bf16_t*)(ws + WS_VS) + ((size_t)b * NKS + PAST + t) * 512 + 8 * lane) = vb;
        }
        if (lane < 8) { const float x = bf1(cu.fl) + a.in[26][lane]; const float lf = fminf(x, 0.f) - log1pf(__expf(-fabsf(x)));
            a.out[(samp ? O_LFS : O_LFP) + (size_t)ml * 8 + lane] = lf; }
        if (t == (samp ? TS - 1 : TP - 1)) { float* so = a.out + (samp ? O_SHS : O_SHP) + (size_t)b * RC;
            for (int c = lane; c < RC; c += 64) so[c] = bf1(pr[c]); }
    }
}

__device__ __forceinline__ void cumsum_block(LAS unsigned char* lds, const float* srcA, int nA, const float* srcB, int ntot, int tpt, float* dst  ) {
    const int tid = threadIdx.x, lane = tid & 63, wid = tid >> 6;
    LAS double* part = (LAS double*)lds;
    const int t0 = tid * tpt; const bool act = t0 < ntot;
    float s[8];
#pragma unroll
    for (int h = 0; h < 8; ++h) s[h] = 0.f;
    if (act) for (int i = 0; i < tpt; ++i) { const int t = t0 + i; const float* p = t < nA ? srcA + (size_t)t * 8 : srcB + (size_t)(t - nA) * 8; const f32x4 v0 = *(const f32x4*)p, v1 = *(const f32x4*)(p + 4);
        s[0] += v0[0]; s[1] += v0[1]; s[2] += v0[2]; s[3] += v0[3]; s[4] += v1[0]; s[5] += v1[1]; s[6] += v1[2]; s[7] += v1[3]; }
#pragma unroll
    for (int h = 0; h < 8; ++h) part[h * 512 + tid] = (double)s[h];
    __syncthreads();
    {
        double v[8]; double run = 0.0;
#pragma unroll
        for (int i = 0; i < 8; ++i) { v[i] = part[wid * 512 + lane * 8 + i]; run += v[i]; }
        double incl = run;
#pragma unroll
        for (int o = 1; o < 64; o <<= 1) { const double y = __shfl_up(incl, o); if (lane >= o) incl += y; }
        double ex = incl - run;
#pragma unroll
        for (int i = 0; i < 8; ++i) { const double tmp = v[i]; part[wid * 512 + lane * 8 + i] = ex; ex += tmp; }
    }
    __syncthreads();
    if (act) { double r[8];
#pragma unroll
        for (int h = 0; h < 8; ++h) r[h] = part[h * 512 + tid];
        for (int i = 0; i < tpt; ++i) { const int t = t0 + i; const float* p = t < nA ? srcA + (size_t)t * 8 : srcB + (size_t)(t - nA) * 8; const f32x4 v0 = *(const f32x4*)p, v1 = *(const f32x4*)(p + 4);
            r[0] += v0[0]; r[1] += v0[1]; r[2] += v0[2]; r[3] += v0[3]; r[4] += v1[0]; r[5] += v1[1]; r[6] += v1[2]; r[7] += v1[3];
#pragma unroll
            for (int h = 0; h < 8; ++h) dst[(size_t)h * ntot + t] = (float)(r[h] * (double)LOG2E); } }
    __syncthreads();
}

constexpr int CL = 64, NCH = TP / CL, SA_ITEMS = 32 * NCH + 64;
constexpr int SA_G = 0, SA_NKM = 16384, SA_AKN = 33024, SA_ABT = 49664, SA_NT = 66048, SA_RT = 75264, SA_BQ = 84480, SA_KQ = 93696, SA_BHK = 102912, SA_KH = 112128,
              SA_ABRT = 121344, SA_AKRT = 130560, SA_GL = 139776, SA_TOT = 140032, SA_Z = SA_BQ, SA_NP = SA_KQ, SA_OUT = 0;
__device__ __forceinline__ f32x4 mm_tile(const LAS unsigned char* X, const LAS unsigned char* Y, int tm, int tn, int lane) {
    f32x4 acc = {0.f, 0.f, 0.f, 0.f};
#pragma unroll
    for (int ks = 0; ks < 2; ++ks) {
        const bf16x8 xa = *(const LAS bf16x8*)(X + (16 * tm + (lane & 15)) * 144 + (32 * ks + 8 * (lane >> 4)) * 2);
        const bf16x8 yb = *(const LAS bf16x8*)(Y + (16 * tn + (lane & 15)) * 144 + (32 * ks + 8 * (lane >> 4)) * 2);
        acc = __builtin_amdgcn_mfma_f32_16x16x32_bf16(xa, yb, acc, 0, 0, 0);
    }
    return acc;
}
template <int u> __device__ __forceinline__ void sub_step(f32x2 (&xp)[32], const LAS float* A) {
    constexpr int G0 = (u + 1) / 4, NV = 16 - G0;
    f32x4 av[NV];
#pragma unroll
    for (int g = 0; g < NV; ++g) av[g] = *(const volatile LAS f32x4*)(A + u * 64 + 4 * (G0 + g));
#pragma unroll
    for (int g = 0; g < NV; ++g) {
        const f32x2 alo = {av[g][0], av[g][1]}, ahi = {av[g][2], av[g][3]};
        if constexpr ((u & 1) == 0)
            asm volatile("v_pk_fma_f32 %0, %2, %3, %0 op_sel_hi:[0,1,1]\n\tv_pk_fma_f32 %1, %2, %4, %1 op_sel_hi:[0,1,1]"
                         : "+v"(xp[2 * (G0 + g)]), "+v"(xp[2 * (G0 + g) + 1]) : "v"(xp[u >> 1]), "v"(alo), "v"(ahi));
        else
            asm volatile("v_pk_fma_f32 %0, %2, %3, %0 op_sel:[1,0,0] op_sel_hi:[1,1,1]\n\tv_pk_fma_f32 %1, %2, %4, %1 op_sel:[1,0,0] op_sel_hi:[1,1,1]"
                         : "+v"(xp[2 * (G0 + g)]), "+v"(xp[2 * (G0 + g) + 1]) : "v"(xp[u >> 1]), "v"(alo), "v"(ahi));
    }
    __builtin_amdgcn_sched_barrier(0);
}
template <int t0, int n> struct SubSteps { static __device__ __forceinline__ void run(f32x2 (&x)[32], const LAS float* A) { sub_step<t0>(x, A); SubSteps<t0 + 1, n - 1>::run(x, A); } };
template <int t0> struct SubSteps<t0, 0> { static __device__ __forceinline__ void run(f32x2 (&)[32], const LAS float*) {} };
struct SaRegs { u32x4 pr, pk, qr, qk, av; f32x4 w0, w1; };
__device__ __forceinline__ void sa_load(const Args& a, int item, SaRegs& R) {
    const int tid = threadIdx.x; unsigned char* ws = a.ws;
    const bf16_t* PR = (const bf16_t*)(ws + WS_PR); const float* WD = (const float*)(ws + WS_WDEC); const bf16_t* AG = (const bf16_t*)(ws + WS_AG);
    const bool samp = item >= 32 * NCH; const int bh = samp ? item - 32 * NCH : item >> 7, c = samp ? 0 : item & 127, b = bh >> 3, h = bh & 7;
    const int row0 = samp ? MP + b * TS : b * TP + c * CL; const int tl = tid >> 3, cgp = tid & 7, c0 = h * 64 + 8 * cgp, m = row0 + tl;
    const bf16_t* p = PR + (size_t)m * RC + c0; const bf16_t* q = PR + (size_t)(m > 0 ? m - 1 : 0) * RC + c0;
    R.pr = *(const u32x4*)p; R.pk = *(const u32x4*)(p + 512); R.qr = *(const u32x4*)q; R.qk = *(const u32x4*)(q + 512);
    R.av = *(const u32x4*)(AG + (size_t)m * 1024 + c0); const float* wp = WD + (size_t)m * 512 + c0; R.w0 = *(const f32x4*)wp; R.w1 = *(const f32x4*)(wp + 4);
}
__device__ __forceinline__ void sa_item(const Args& a, LAS unsigned char* lds, int item, const SaRegs& R, int prev_item) {
    const int tid = threadIdx.x, lane = tid & 63, wid = __builtin_amdgcn_readfirstlane(tid >> 6);
    unsigned char* ws = a.ws;
    const bf16_t* PR = (const bf16_t*)(ws + WS_PR); const float* WD = (const float*)(ws + WS_WDEC); const bf16_t* AG = (const bf16_t*)(ws + WS_AG); float* RK = (float*)(ws + WS_RK);
    const bool samp = item >= 32 * NCH; const int bh = samp ? item - 32 * NCH : item >> 7, c = samp ? 0 : item & 127, b = bh >> 3, h = bh & 7;
    const int row0 = samp ? MP + b * TS : b * TP + c * CL;
    const float* shift0 = samp ? a.in[6] + (size_t)b * RC : nullptr;
    LAS float* G = (LAS float*)(lds + SA_G); LAS float* GL = (LAS float*)(lds + SA_GL); LAS float* TOT = (LAS float*)(lds + SA_TOT);
    const int tl = tid >> 3, cgp = tid & 7, c0 = h * 64 + 8 * cgp, m = row0 + tl;
    float zr[8], nk[8], bb[8], kp[8];
    {
        float pr[8], pk[8], qr[8], qk[8], av[8];
        unpack8(R.pr, pr); unpack8(R.pk, pk); unpack8(R.qr, qr); unpack8(R.qk, qk); unpack8(R.av, av);
        const f32x4 w0 = R.w0, w1 = R.w1;
        if (c == 0 && tl == 0) {
#pragma unroll
            for (int j = 0; j < 8; ++j) { qr[j] = shift0 ? shift0[c0 + j] : 0.f; qk[j] = shift0 ? shift0[512 + c0 + j] : 0.f; }
        }
        const f32x4* m4 = (const f32x4*)(a.in[13] + c0); const f32x4 x0 = m4[0], x1 = m4[1], y0 = m4[128], y1 = m4[129];
        const f32x4* k4p = (const f32x4*)(a.in[19] + c0); const f32x4* a4p = (const f32x4*)(a.in[20] + c0); const f32x4* r4p = (const f32x4*)(a.in[21] + c0);
        const f32x4 kk0 = k4p[0], kk1 = k4p[1], ka0 = a4p[0], ka1 = a4p[1], rk0 = r4p[0], rk1 = r4p[1];
        float mur[8], muk[8], kkw[8], kaw[8], rkw[8];
#pragma unroll
        for (int j = 0; j < 4; ++j) { mur[j] = x0[j]; mur[4 + j] = x1[j]; muk[j] = y0[j]; muk[4 + j] = y1[j]; kkw[j] = kk0[j]; kkw[4 + j] = kk1[j]; kaw[j] = ka0[j]; kaw[4 + j] = ka1[j]; rkw[j] = rk0[j]; rkw[4 + j] = rk1[j]; }
        float zk[8], kk[8]; float ss = 0.f;
#pragma unroll
        for (int j = 0; j < 8; ++j) { zr[j] = pr[j] + (qr[j] - pr[j]) * mur[j]; zk[j] = pk[j] + (qk[j] - pk[j]) * muk[j]; kk[j] = zk[j] * kkw[j]; ss += kk[j] * kk[j]; }
        const float inv = 1.0f / fmaxf(sqrtf(sum8(ss)), 1e-12f); float rk = 0.f;
#pragma unroll
        for (int j = 0; j < 8; ++j) { const float kn = kk[j] * inv; nk[j] = -kn; bb[j] = kn * av[j]; kp[j] = zk[j] * (1.f + (av[j] - 1.f) * kaw[j]); rk += zr[j] * kp[j] * rkw[j]; }
        rk = sum8(rk);
        if (cgp == 0) RK[(size_t)m * 8 + h] = rk;
        *(LAS f32x4*)(G + tl * 64 + 8 * cgp) = w0; *(LAS f32x4*)(G + tl * 64 + 8 * cgp + 4) = w1;
    }
    __syncthreads();
    {
        const int k = tid & 63, part = tid >> 6; float run = 1.f; float g8[8];
#pragma unroll
        for (int i = 0; i < 8; ++i) g8[i] = G[(8 * part + i) * 64 + k];
#pragma unroll
        for (int i = 0; i < 8; ++i) { run *= g8[i]; g8[i] = run; }
        TOT[part * 64 + k] = run;
        __syncthreads();
        float tt[8];
#pragma unroll
        for (int p2 = 0; p2 < 8; ++p2) tt[p2] = TOT[p2 * 64 + k];
        float pre = 1.f;
#pragma unroll
        for (int p2 = 0; p2 < 8; ++p2) pre *= (p2 < part) ? tt[p2] : 1.f;
#pragma unroll
        for (int i = 0; i < 8; ++i) G[(8 * part + i) * 64 + k] = g8[i] * pre;
        if (part == 7) GL[k] = run * pre;
    }
    __syncthreads();
    {
        float nt[8], rt[8], bq[8], kq[8], bh8[8], kh8[8];
        const f32x4 gA = *(const LAS f32x4*)(G + tl * 64 + 8 * cgp), gB = *(const LAS f32x4*)(G + tl * 64 + 8 * cgp + 4), lA = *(const LAS f32x4*)(GL + 8 * cgp), lB = *(const LAS f32x4*)(GL + 8 * cgp + 4);
        const int tlp = tl > 0 ? tl - 1 : 0; const f32x4 pA = *(const LAS f32x4*)(G + tlp * 64 + 8 * cgp), pB = *(const LAS f32x4*)(G + tlp * 64 + 8 * cgp + 4);
#pragma unroll
        for (int j = 0; j < 8; ++j) { const float g = j < 4 ? gA[j & 3] : gB[j & 3], gp = tl > 0 ? (j < 4 ? pA[j & 3] : pB[j & 3]) : 1.f, gl = j < 4 ? lA[j & 3] : lB[j & 3], ig = __builtin_amdgcn_rcpf(g);
            nt[j] = gp * nk[j]; rt[j] = g * zr[j]; bq[j] = bb[j] * ig; kq[j] = kp[j] * ig; bh8[j] = bq[j] * gl; kh8[j] = kq[j] * gl; }
        *(LAS u32x4*)(lds + SA_NT + tl * 144 + cgp * 16) = pack8(nt); *(LAS u32x4*)(lds + SA_RT + tl * 144 + cgp * 16) = pack8(rt);
        *(LAS u32x4*)(lds + SA_BQ + tl * 144 + cgp * 16) = pack8(bq); *(LAS u32x4*)(lds + SA_KQ + tl * 144 + cgp * 16) = pack8(kq);
        *(LAS u32x4*)(lds + SA_KH + tl * 144 + cgp * 16) = pack8(kh8);
#pragma unroll
        for (int j = 0; j < 8; ++j) { const int k = 8 * cgp + j;
            ((LAS float*)(lds + SA_NKM))[k * 65 + tl] = nt[j]; ((LAS bf16_t*)(lds + SA_BHK))[k * 72 + tl] = (bf16_t)f2bf(bh8[j]); }
    }
    __syncthreads();
    {
        const int prod = wid >> 1, half = wid & 1;
        const LAS unsigned char* X = lds + ((prod & 1) ? SA_KQ : SA_BQ); const LAS unsigned char* Yb = lds + ((prod & 2) ? SA_RT : SA_NT);
        for (int ti = 0; ti < 8; ++ti) { const int tile = half * 8 + ti, tm = tile >> 2, tn = tile & 3;
            f32x4 acc = mm_tile(X, Yb, tm, tn, lane);
            const int s0 = 16 * tm + 4 * (lane >> 4), t = 16 * tn + (lane & 15);
#pragma unroll
            for (int r = 0; r < 4; ++r) { const int s = s0 + r; const bool keep = (prod & 2) ? (s <= t) : (s < t); if (!keep) acc[r] = 0.f; }
            if (prod == 0) { LAS float* o = (LAS float*)(lds + SA_ABT);
#pragma unroll
                for (int r = 0; r < 4; ++r) o[(s0 + r) * 64 + t] = acc[r]; }
            else if (prod == 1) { LAS float* o = (LAS float*)(lds + SA_AKN);
#pragma unroll
                for (int r = 0; r < 4; ++r) o[(s0 + r) * 65 + t] = acc[r]; }
            else { u32x2 w; w.x = pk2(acc[0], acc[1]); w.y = pk2(acc[2], acc[3]);
                *(LAS u32x2*)(lds + (prod == 2 ? SA_ABRT : SA_AKRT) + t * 144 + s0 * 2) = w; }
        }
    }
    if (prev_item >= 0) asm volatile("s_waitcnt vmcnt(0)" ::: "memory");
    __syncthreads();
    if (prev_item >= 0 && tid == 0) __hip_atomic_store((unsigned*)(ws + WS_CTL) + 1024 + prev_item, 1u, __ATOMIC_RELAXED, __HIP_MEMORY_SCOPE_AGENT);
    if (wid < 2) {
        const LAS float* rhs = (const LAS float*)(lds + (wid == 0 ? SA_AKN : SA_NKM)) + lane * 65; const LAS float* At = (const LAS float*)(lds + SA_ABT);
        f32x2 xp[32];
#pragma unroll
        for (int t = 0; t < 32; ++t) xp[t] = (f32x2){rhs[2 * t], rhs[2 * t + 1]};
        SubSteps<0, 63>::run(xp, At);
        LAS unsigned char* o = lds + (wid == 0 ? SA_Z : SA_NP) + lane * 144;
#pragma unroll
        for (int g8 = 0; g8 < 8; ++g8) { u32x4 w; w.x = pk2(xp[4 * g8][0], xp[4 * g8][1]); w.y = pk2(xp[4 * g8 + 1][0], xp[4 * g8 + 1][1]); w.z = pk2(xp[4 * g8 + 2][0], xp[4 * g8 + 2][1]); w.w = pk2(xp[4 * g8 + 3][0], xp[4 * g8 + 3][1]); *(LAS u32x4*)(o + g8 * 16) = w; }
    }
    __syncthreads();
    {
        const int prod = wid >> 1, half = wid & 1;
        const LAS unsigned char* X = lds + ((prod == 0 || prod == 3) ? SA_BHK : SA_ABRT); const LAS unsigned char* Yb = lds + ((prod < 2) ? SA_NP : SA_Z);
        LAS bf16_t* OUT = (LAS bf16_t*)(lds + SA_OUT);
        const int rbase = (prod == 0 || prod == 3) ? 64 : 0, cbase = (prod < 2) ? 0 : 64;
        for (int ti = 0; ti < 8; ++ti) { const int tile = half * 8 + ti, tm = tile >> 2, tn = tile & 3;
            f32x4 acc = mm_tile(X, Yb, tm, tn, lane);
            const int m0 = 16 * tm + 4 * (lane >> 4), n = 16 * tn + (lane & 15);
            const LAS bf16_t* ap = (const LAS bf16_t*)(lds + (prod == 1 ? SA_RT : prod == 2 ? SA_AKRT : SA_KH)) + (prod == 3 ? n * 72 + m0 : m0 * 72 + n);
            const int st = (prod == 3) ? 1 : 72;
            const bf16_t a0 = ap[0], a1 = ap[st], a2 = ap[2 * st], a3 = ap[3 * st]; const float gl = GL[n];
            float addv[4] = {bf1(a0), bf1(a1), bf1(a2), bf1(a3)};
            if (prod == 0) {
#pragma unroll
                for (int r = 0; r < 4; ++r) addv[r] = (m0 + r == n) ? gl : 0.f; }
#pragma unroll
            for (int r = 0; r < 4; ++r) OUT[(rbase + m0 + r) * 136 + cbase + n] = (bf16_t)f2bf(acc[r] + addv[r]); }
    }
    __syncthreads();
    {
        unsigned char* dst = (unsigned char*)(a.out + O_Y) + (size_t)item * 32768;
#pragma unroll
        for (int ps = 0; ps < 4; ++ps) { const int idx = ps * 512 + tid, row = idx >> 4, ch = idx & 15;
            const u32x4 v = *(const LAS u32x4*)(lds + SA_OUT + row * 272 + ch * 16); unsigned char* gp = dst + row * 256 + ch * 16;
            asm volatile("global_store_dwordx4 %0, %1, off sc1\n\ts_nop 1" :: "v"(gp), "v"(v) : "memory"); }
    }
    __syncthreads();
}

constexpr int SB_A = 0, SB_B0 = 17408, SB_B1 = 17408 + 34816;
__device__ __forceinline__ void sb_chain(const Args& a, LAS unsigned char* lds, int item0, int nch, int row0, int h, const float* S0, float* Sout, const float* shift0) {
    const int tid = threadIdx.x, lane = tid & 63, wid = __builtin_amdgcn_readfirstlane(tid >> 6);
    unsigned char* ws = a.ws;
    const bf16_t* PR = (const bf16_t*)(ws + WS_PR); float* Y = (float*)(ws + WS_Y);
    LAS bf16_t* AI = (LAS bf16_t*)(lds + SB_A);
    const int tl = tid >> 3, cgp = tid & 7, c0 = 1024 + h * 64 + 8 * cgp;
    const f32x4 mv0 = *(const f32x4*)(a.in[13] + c0), mv1 = *(const f32x4*)(a.in[13] + c0 + 4);
    struct ChunkRegs { u32x4 b[4], pv, qv; };
    ChunkRegs r0, r1, r2, r3;
    auto load_chunk = [&](int c, ChunkRegs& R) {
        const unsigned char* src = (const unsigned char*)(a.out + O_Y) + (size_t)(item0 + c) * 32768;
#pragma unroll
        for (int ps = 0; ps < 4; ++ps) R.b[ps] = *(const u32x4*)(src + (ps * 512 + tid) * 16);
        const int m = row0 + c * CL + tl; R.pv = *(const u32x4*)(PR + (size_t)m * RC + c0); R.qv = *(const u32x4*)(PR + (size_t)(m > 0 ? m - 1 : 0) * RC + c0); };
    auto store_chunk = [&](int c, const ChunkRegs& R) {
        LAS unsigned char* B = lds + ((c & 1) ? SB_B1 : SB_B0);
#pragma unroll
        for (int ps = 0; ps < 4; ++ps) { const int idx = ps * 512 + tid, row = idx >> 4, ch = idx & 15; *(LAS u32x4*)(B + row * 272 + ch * 16) = R.b[ps]; }
        float pv[8], qv[8]; unpack8(R.pv, pv); unpack8(R.qv, qv);
        if (c == 0 && tl == 0) {
#pragma unroll
            for (int j = 0; j < 8; ++j) qv[j] = shift0 ? shift0[c0 + j] : 0.f; }
        const float mu[8] = {mv0[0], mv0[1], mv0[2], mv0[3], mv1[0], mv1[1], mv1[2], mv1[3]};
#pragma unroll
        for (int j = 0; j < 8; ++j) AI[(8 * cgp + j) * 136 + 64 + tl] = (bf16_t)f2bf(pv[j] + (qv[j] - pv[j]) * mu[j]); };
    for (int e = tid; e < 4096; e += 512) AI[(e >> 6) * 136 + (e & 63)] = S0 ? (bf16_t)f2bf(S0[e]) : (bf16_t)0;
    unsigned* flags = (unsigned*)(ws + WS_CTL) + 1024 + item0;
    int ready = 0;
#define SB_WAIT_BATCH() do { const int hi_ = (ready + 16 < nch) ? ready + 16 : nch; \
        if (tid == 0) { for (;;) { unsigned v_ = 1u; for (int k_ = ready; k_ < hi_; ++k_) { const unsigned f_ = __hip_atomic_load(flags + k_, __ATOMIC_RELAXED, __HIP_MEMORY_SCOPE_AGENT); v_ = f_ < v_ ? f_ : v_; } \
                if (v_ != 0u) break; __builtin_amdgcn_s_sleep(8); } \
            __builtin_amdgcn_fence(__ATOMIC_ACQUIRE, "agent"); asm volatile("s_waitcnt vmcnt(0)" ::: "memory"); } \
        ready = hi_; } while (0)
    SB_WAIT_BATCH();
    __syncthreads();
    load_chunk(0, r0); store_chunk(0, r0);
    if (nch > 1) load_chunk(1, r1);
    if (nch > 2) load_chunk(2, r2);
    if (nch > 3) load_chunk(3, r3);
    if (nch > 4) load_chunk(4, r0);
    __syncthreads();
    const int tm = wid & 3, tn0 = 4 * (wid >> 2);
    f32x4 acc[4];
#define SB_STEP(c, RN) do { \
        const LAS unsigned char* B = lds + (((c) & 1) ? SB_B1 : SB_B0); \
        _Pragma("unroll") for (int q = 0; q < 4; ++q) acc[q] = (f32x4){0.f, 0.f, 0.f, 0.f}; \
        _Pragma("unroll") for (int ks = 0; ks < 4; ++ks) { \
            const bf16x8 xa = *(const LAS bf16x8*)(lds + SB_A + (16 * tm + (lane & 15)) * 272 + (32 * ks + 8 * (lane >> 4)) * 2); \
            _Pragma("unroll") for (int q = 0; q < 4; ++q) { const bf16x8 yb = *(const LAS bf16x8*)(B + (16 * (tn0 + q) + (lane & 15)) * 272 + (32 * ks + 8 * (lane >> 4)) * 2); \
                acc[q] = __builtin_amdgcn_mfma_f32_16x16x32_bf16(xa, yb, acc[q], 0, 0, 0); } } \
        const int i0 = 16 * tm + 4 * (lane >> 4); \
        if (wid < 4) { _Pragma("unroll") for (int q = 0; q < 4; ++q) { const int t = 16 * q + (lane & 15); *(f32x4*)(Y + (size_t)(row0 + (c) * CL + t) * 512 + h * 64 + i0) = acc[q]; } } \
        __syncthreads(); \
        if (wid >= 4) { \
            _Pragma("unroll") for (int q = 0; q < 4; ++q) { const int kq = 16 * q + (lane & 15); _Pragma("unroll") for (int r = 0; r < 4; ++r) AI[(i0 + r) * 136 + kq] = (bf16_t)f2bf(acc[q][r]); } \
            if ((c) == nch - 1) { _Pragma("unroll") for (int q = 0; q < 4; ++q) { const int kq = 16 * q + (lane & 15); _Pragma("unroll") for (int r = 0; r < 4; ++r) Sout[(size_t)(i0 + r) * 64 + kq] = acc[q][r]; } } } \
        if ((c) + 1 < nch) store_chunk((c) + 1, RN); \
        if ((c) + 5 < nch && (c) + 5 >= ready) SB_WAIT_BATCH(); \
        __syncthreads(); \
        if ((c) + 5 < nch) load_chunk((c) + 5, RN); } while (0)
    for (int c = 0; c < nch; c += 4) {
        SB_STEP(c, r1);
        if (c + 1 < nch) SB_STEP(c + 1, r2);
        if (c + 2 < nch) SB_STEP(c + 2, r3);
        if (c + 3 < nch) SB_STEP(c + 3, r0);
    }
#undef SB_STEP
#undef SB_WAIT_BATCH
}

constexpr int AT_K0 = 0, AT_K1 = 9216, AT_V0 = 18432, AT_V1 = 30720, AT_NB0 = 43008, AT_NB1 = 43264, AT_WSF = 43520, AT_CNT = 45568;
__device__ __forceinline__ void attn_unit(LAS unsigned char* lds, const bf16_t* Q, int ldq, const bf16_t* K, const bf16_t* V, int ldkv, const float* lc2,
                                          bf16_t* O, int ldo, int nq_valid, int qpos0, float U2x2, float T2) {
    const int tid = threadIdx.x, lane = tid & 63, r32 = lane & 31, hi = lane >> 5, wid = __builtin_amdgcn_readfirstlane(tid >> 6);
    const int jmax = (qpos0 + nq_valid - 1) >> 6, ntile = jmax + 1;
    LAS float* wsf = (LAS float*)(lds + AT_WSF) + wid * 64; LAS int* cnt = (LAS int*)(lds + AT_CNT);
    const float Lq0 = lc2[qpos0];
    bool drop = false;
    if (tid < ntile) { const int kend = 64 * tid + 63; if (kend <= qpos0) drop = (Lq0 - lc2[kend] + U2x2 < -T2); }
    { const unsigned long long bal = __ballot(drop); if (lane == 0) cnt[wid] = __popcll(bal); }
    __syncthreads();
    int tlo = 0;
#pragma unroll
    for (int w = 0; w < 8; ++w) tlo += cnt[w];
    const float Lref = lc2[64 * tlo];
    const bool active = 32 * wid < nq_valid;
    const int qp_lo = qpos0 + 32 * wid, qp_hi = qp_lo + 31, qpos = qp_lo + r32;
    const float Lqw = active ? lc2[qp_lo] - Lref : 0.f;
    bf16x8 qr[4];
    if (active) {
#pragma unroll
        for (int d0 = 0; d0 < 4; ++d0) qr[d0] = *(const bf16x8*)(Q + (size_t)(32 * wid + r32) * ldq + d0 * 16 + hi * 8);
    } else {
#pragma unroll
        for (int d0 = 0; d0 < 4; ++d0) qr[d0] = (bf16x8){0, 0, 0, 0, 0, 0, 0, 0};
    }
    float m_run = -1e30f, l_run = 0.f; f32x16 o0 = {}, o1 = {};
    const int srow = tid >> 3, sch = tid & 7;
    u32x4 kreg, vreg; float nbreg = 0.f;
    auto load_tile = [&](int j) {
        kreg = *(const u32x4*)(K + (size_t)(64 * j + srow) * ldkv + 8 * sch); vreg = *(const u32x4*)(V + (size_t)(64 * j + srow) * ldkv + 8 * sch);
        if (tid < 64) nbreg = Lref - lc2[64 * j + tid]; };
    auto store_tile = [&](int b) {
        *(LAS u32x4*)(lds + (b ? AT_K1 : AT_K0) + srow * 144 + sch * 16) = kreg; *(LAS u32x4*)(lds + (b ? AT_V1 : AT_V0) + srow * 192 + sch * 16) = vreg;
        if (tid < 64) ((LAS float*)(lds + (b ? AT_NB1 : AT_NB0)))[tid] = nbreg; };
    load_tile(jmax); store_tile(0);
    __syncthreads();
    int buf = 0;
    for (int j = jmax; j >= tlo; --j) {
        if (j > tlo) load_tile(j - 1);
        const LAS unsigned char* Kt = lds + (buf ? AT_K1 : AT_K0); const LAS unsigned char* Vt = lds + (buf ? AT_V1 : AT_V0); const LAS float* NB = (const LAS float*)(lds + (buf ? AT_NB1 : AT_NB0));
        bool need = active && (64 * j <= qp_hi);
        if (need && (64 * j + 63 < qp_lo)) need = (Lqw + NB[63] + U2x2 >= -T2);
        if (need) {
            f32x16 p0 = {}, p1 = {};
#pragma unroll
            for (int d0 = 0; d0 < 4; ++d0) { const bf16x8 a0 = *(const LAS bf16x8*)(Kt + r32 * 144 + d0 * 32 + hi * 16), a1 = *(const LAS bf16x8*)(Kt + (32 + r32) * 144 + d0 * 32 + hi * 16);
                p0 = __builtin_amdgcn_mfma_f32_32x32x16_bf16(a0, qr[d0], p0, 0, 0, 0); p1 = __builtin_amdgcn_mfma_f32_32x32x16_bf16(a1, qr[d0], p1, 0, 0, 0); }
#pragma unroll
            for (int aa = 0; aa < 4; ++aa) { const f32x4 n0 = *(const LAS f32x4*)(NB + 8 * aa + 4 * hi), n1 = *(const LAS f32x4*)(NB + 32 + 8 * aa + 4 * hi);
#pragma unroll
                for (int b = 0; b < 4; ++b) { p0[4 * aa + b] += n0[b]; p1[4 * aa + b] += n1[b]; } }
            if (64 * j + 63 > qp_lo) {
#pragma unroll
                for (int r = 0; r < 16; ++r) { const int key = 64 * j + (r & 3) + 8 * (r >> 2) + 4 * hi; if (key > qpos) p0[r] = -1e30f; if (key + 32 > qpos) p1[r] = -1e30f; }
            }
            float rm = fmaxf(p0[0], p1[0]);
#pragma unroll
            for (int r = 1; r < 16; ++r) rm = fmaxf(rm, fmaxf(p0[r], p1[r]));
            rm = fmaxf(rm, __shfl_xor(rm, 32));
            if (__any(rm > m_run)) {
                const float mn = fmaxf(m_run, rm), f = __builtin_amdgcn_exp2f(m_run - mn); l_run *= f; m_run = mn;
                if (hi == 0) wsf[r32] = f;
                asm volatile("s_waitcnt lgkmcnt(0)" ::: "memory");
#pragma unroll
                for (int aa = 0; aa < 4; ++aa) { const f32x4 f4 = *(const LAS f32x4*)(wsf + 8 * aa + 4 * hi);
#pragma unroll
                    for (int b = 0; b < 4; ++b) { o0[4 * aa + b] *= f4[b]; o1[4 * aa + b] *= f4[b]; } }
            }
            float ls = 0.f;
#pragma unroll
            for (int r = 0; r < 16; ++r) { p0[r] = __builtin_amdgcn_exp2f(p0[r] - m_run); p1[r] = __builtin_amdgcn_exp2f(p1[r] - m_run); ls += p0[r] + p1[r]; }
            l_run += ls;
            bf16x8 pa[4];
#pragma unroll
            for (int s = 0; s < 4; ++s) { u32x4 w;
                if (s < 2) { w.x = pk2(p0[8 * s + 0], p0[8 * s + 1]); w.y = pk2(p0[8 * s + 2], p0[8 * s + 3]); w.z = pk2(p0[8 * s + 4], p0[8 * s + 5]); w.w = pk2(p0[8 * s + 6], p0[8 * s + 7]); }
                else { const int s2 = s - 2; w.x = pk2(p1[8 * s2 + 0], p1[8 * s2 + 1]); w.y = pk2(p1[8 * s2 + 2], p1[8 * s2 + 3]); w.z = pk2(p1[8 * s2 + 4], p1[8 * s2 + 5]); w.w = pk2(p1[8 * s2 + 6], p1[8 * s2 + 7]); }
                pa[s] = __builtin_bit_cast(bf16x8, w); }
            const LAS unsigned char* vb = Vt + (4 * hi + ((lane & 15) >> 2)) * 192 + (16 * ((lane >> 4) & 1) + 4 * (lane & 3)) * 2;
#pragma unroll
            for (int s = 0; s < 4; ++s) { const int kvb = (s & 1) * 16 + (s >> 1) * 32;
#pragma unroll
                for (int dh = 0; dh < 2; ++dh) { const LAS unsigned char* p = vb + kvb * 192 + dh * 64;
                    const v4i16_t lo = __builtin_amdgcn_ds_read_tr16_b64_v4i16((LAS v4i16_t*)p), hi4 = __builtin_amdgcn_ds_read_tr16_b64_v4i16((LAS v4i16_t*)(p + 8 * 192));
                    const bf16x8 bv = (bf16x8){lo[0], lo[1], lo[2], lo[3], hi4[0], hi4[1], hi4[2], hi4[3]};
                    if (dh == 0) o0 = __builtin_amdgcn_mfma_f32_32x32x16_bf16(pa[s], bv, o0, 0, 0, 0); else o1 = __builtin_amdgcn_mfma_f32_32x32x16_bf16(pa[s], bv, o1, 0, 0, 0); } }
        }
        if (j > tlo) store_tile(buf ^ 1);
        __syncthreads();
        buf ^= 1;
    }
    if (active) {
        const float lt = l_run + __shfl_xor(l_run, 32);
        if (hi == 0) wsf[32 + r32] = 1.0f / lt;
        asm volatile("s_waitcnt lgkmcnt(0)" ::: "memory");
#pragma unroll
        for (int aa = 0; aa < 4; ++aa) { const f32x4 i4 = *(const LAS f32x4*)(wsf + 32 + 8 * aa + 4 * hi);
#pragma unroll
            for (int b = 0; b < 4; ++b) { const int q = 32 * wid + 8 * aa + 4 * hi + b; bf16_t* op = O + (size_t)q * ldo + r32;
                op[0] = (bf16_t)f2bf(o0[4 * aa + b] * i4[b]); op[32] = (bf16_t)f2bf(o1[4 * aa + b] * i4[b]); } }
    }
    __syncthreads();
}

__device__ __forceinline__ void phase5(const Args& a, LAS unsigned char* lds) {
    const int tid = threadIdx.x, lane = tid & 63;
    unsigned char* ws = a.ws;
    float gq = fabsf(a.in[24][lane]), gk = fabsf(a.in[25][lane]);
#pragma unroll
    for (int o = 1; o < 64; o <<= 1) { gq = fmaxf(gq, __shfl_xor(gq, o)); gk = fmaxf(gk, __shfl_xor(gk, o)); }
    const float U2x2 = 2.0f * 8.0f * gq * gk * LOG2E * 1.03f + 0.5f, T2 = 20.0f * LOG2E;
    unsigned* ctr = (unsigned*)(ws + WS_CTL) + 64; LAS unsigned* su = (LAS unsigned*)(lds + AT_CNT + 64);
    bf16_t* PF = (bf16_t*)(ws + WS_PF);
    for (;;) {
        if (tid == 0) *su = atomicAdd(ctr, 1u);
        __syncthreads();
        const unsigned u = *su;
        __syncthreads();
        if (u >= 1024u + 64u) break;
        if (u < 1024u) { const int bh = u >> 5, qb = u & 31, b = bh >> 3, h = bh & 7; bf16_t* base = PF + (size_t)(b * TP) * RC + h * 64;
            attn_unit(lds, base + (size_t)(256 * qb) * RC, RC, base + 512, base + 1024, RC, (const float*)(ws + WS_LCP) + (size_t)bh * TP, base + (size_t)(256 * qb) * RC, RC, 256, 256 * qb, U2x2, T2); }
        else { const int bh = u - 1024, b = bh >> 3, h = bh & 7; bf16_t* qb_ = PF + (size_t)(MP + b * TS) * RC + h * 64;
            attn_unit(lds, qb_, RC, (const bf16_t*)(ws + WS_KS) + (size_t)b * NKS * 512 + h * 64, (const bf16_t*)(ws + WS_VS) + (size_t)b * NKS * 512 + h * 64, 512,
                      (const float*)(ws + WS_LCS) + (size_t)bh * NKS, qb_, RC, TS, PAST, U2x2, T2); }
    }
}

__device__ __forceinline__ void phase6(const Args& a, const pg8::RowSet rs, int rank, int pool, int opq) {
    const int tidq = threadIdx.x + opq; const int lane = tidq & 63, gw = rank * 8 + (tidq >> 6), NGW = pool * 8;
    unsigned char* ws = a.ws;
    const bf16_t* PR = (const bf16_t*)(ws + WS_PR); bf16_t* PF = (bf16_t*)(ws + WS_PF); const bf16_t* AG = (const bf16_t*)(ws + WS_AG);
    const float* Y = (const float*)(ws + WS_Y); const float* RK = (const float*)(ws + WS_RK);
    const int c = 8 * lane, nr = rs.nrows();
    struct P6Regs { f32x4 y0, y1; u32x4 pv, qv, g; float rk; };
    P6Regs nx;
    auto ldrow = [&](int r) { const int m = rs.grow(r);
        nx.y0 = *(const f32x4*)(Y + (size_t)m * 512 + c); nx.y1 = *(const f32x4*)(Y + (size_t)m * 512 + c + 4);
        nx.pv = *(const u32x4*)(PR + (size_t)m * RC + 1024 + c); nx.qv = *(const u32x4*)(PR + (size_t)(m > 0 ? m - 1 : 0) * RC + 1024 + c);
        nx.g = *(const u32x4*)(AG + (size_t)m * 1024 + 512 + c); nx.rk = RK[(size_t)m * 8 + (lane >> 3)]; };
    if (gw < nr) ldrow(gw);
    for (int r = gw; r < nr; r += NGW) {
        const int m = rs.grow(r);
        const bool samp = m >= MP; const int ml = samp ? m - MP : m; const int b = samp ? (ml >> 6) : (ml >> 13); const int t = samp ? (ml & 63) : (ml & 8191);
        const P6Regs cu = nx;
        if (r + NGW < nr) ldrow(r + NGW);
        const f32x4 y0 = cu.y0, y1 = cu.y1;
        float y[8] = {y0[0], y0[1], y0[2], y0[3], y1[0], y1[1], y1[2], y1[3]}; float s = 0.f;
#pragma unroll
        for (int j = 0; j < 8; ++j) s += y[j];
        const float mean = sum8(s) * (1.f / 64.f); float q = 0.f;
#pragma unroll
        for (int j = 0; j < 8; ++j) { y[j] -= mean; q += y[j] * y[j]; }
        const float rstd = rsqrtf(sum8(q) * (1.f / 64.f) + 64e-5f);
        float pv[8], qv[8], g[8]; unpack8(cu.pv, pv);
        if (t > 0) unpack8(cu.qv, qv);
        else {
#pragma unroll
            for (int j = 0; j < 8; ++j) qv[j] = samp ? a.in[6][(size_t)b * RC + 1024 + c + j] : 0.f; }
        unpack8(cu.g, g);
        const float rk = cu.rk; float o[8];
#pragma unroll
        for (int j = 0; j < 8; ++j) { const float zv = pv[j] + (qv[j] - pv[j]) * a.in[13][1024 + c + j]; o[j] = (y[j] * rstd * a.in[22][c + j] + a.in[23][c + j] + rk * zv) * g[j]; }
        *(u32x4*)(PF + (size_t)m * RC + 512 + c) = pack8(o);
    }
}
__device__ __forceinline__ void norm2_rows(const Args& a, const pg8::RowSet rs, int rank, int pool, const float* X1b, bf16_t* H2b, const float* mod, int opq) {
    const int tidq = threadIdx.x + opq; const int lane = tidq & 63, gw = rank * 8 + (tidq >> 6), NGW = pool * 8, nr = rs.nrows();
    const float* gvec = a.in[28];
    f32x4 nx[4];
    auto ldrow = [&](int r) { const float* xr = X1b + (size_t)rs.grow(r) * DM;
#pragma unroll
        for (int j = 0; j < 4; ++j) nx[j] = *(const f32x4*)(xr + 4 * lane + 256 * j); };
    if (gw < nr) ldrow(gw);
    for (int r = gw; r < nr; r += NGW) {
        const int m = rs.grow(r); const size_t br = (size_t)rs.brow(r);
        const float* mr = mod + (size_t)batch_of_row(m) * 6144;
        f32x4 v[4]; float s = 0.f;
#pragma unroll
        for (int j = 0; j < 4; ++j) { v[j] = nx[j]; s += (v[j][0] * v[j][0] + v[j][1] * v[j][1]) + (v[j][2] * v[j][2] + v[j][3] * v[j][3]); }
        if (r + NGW < nr) ldrow(r + NGW);
        const float rinv = rsqrtf(wave_sum(s) * (1.f / DM) + 1e-6f);
#pragma unroll
        for (int j = 0; j < 4; ++j) { const int c = 4 * lane + 256 * j; const f32x4 g = *(const f32x4*)(gvec + c), sc = *(const f32x4*)(mr + 4096 + c), sh = *(const f32x4*)(mr + 3072 + c);
            f32x4 o;
#pragma unroll
            for (int q = 0; q < 4; ++q) o[q] = v[j][q] * rinv * g[q] * (1.f + sc[q]) + sh[q];
            u32x2 w; w.x = pk2(o[0], o[1]); w.y = pk2(o[2], o[3]); *(u32x2*)(H2b + br * DM + c) = w; }
    }
}

constexpr int NPHASE = 6;

__global__ void __launch_bounds__(512, 2) mk_fwd(Args a) {
    extern __shared__ __attribute__((aligned(16))) unsigned char lds_raw[];
    LAS unsigned char* lds = (LAS unsigned char*)lds_raw;
    cg::grid_group grid = cg::this_grid();
#define GRID_BAR() do { XcdBarrier xb_; xb_.bar = (unsigned*)(a.ws + WS_CTL) + 6000; xb_.x = xb_xcc_id(); xb_.st = (volatile LAS unsigned*)(lds + 147200); xcd_barrier(xb_, false); } while (0)
#define GRID_BAR_FIRST() do { XcdBarrier xb_; xb_.bar = (unsigned*)(a.ws + WS_CTL) + 6000; xb_.x = xb_xcc_id(); xb_.st = (volatile LAS unsigned*)(lds + 147200); xcd_barrier(xb_, true); } while (0)
    unsigned char* ws = a.ws;
    const int lo = a.ph_lo, hi = a.ph_hi, G = gridDim.x, blk = blockIdx.x;
#define IN(k) (lo <= (k) && (k) < hi)
#define SEAM(k) do { if (IN(k) && IN((k) + 1)) { if (lo < 0) grid.sync(); else if ((k) == lo) GRID_BAR_FIRST(); else GRID_BAR(); } } while (0)
    float* mod = (float*)(ws + WS_MOD);
    if (IN(0)) { for (int rep = 0; rep < REP_ROWS; ++rep) phase0(a, lds); } SEAM(0);
    if (IN(1)) { for (int rep = 0; rep < REP_ROWS; ++rep) norm_rows(a.in[0], a.in[1], a.in[9], mod, 0, 1024, (bf16_t*)(ws + WS_XN)); } SEAM(1);
    if (IN(2)) { pg8::Gemm g{(const bf16_t*)(ws + WS_XN), (const bf16_t*)(ws + WS_WIN), MT, NPAD, 1024, 1024}; pg8::StaticOrder S; S.init(MT, NPAD, G, blk);
        pg8::EpiProj E{(bf16_t*)(ws + WS_PR), (bf16_t*)(ws + WS_PF)}; pg8::gemm_phase<pg8::EpiProj, pg8::StaticOrder, true>(lds, g, S, E); } SEAM(2);
    if (IN(3)) { phase3(a); } SEAM(3);
    if (IN(4)) {
        {
            const int it = (G >= 12) ? blk - (G - 12) : -1;
            if (it >= 0) {
                const bool pr = it < 4; const int b = pr ? it : it - 4;
                const float* sA = pr ? a.out + O_LFP + (size_t)b * TP * 8 : a.in[4] + (size_t)b * PAST * 8;
                const float* sB = a.out + O_LFS + (size_t)b * TS * 8;
                float* dst = pr ? (float*)(ws + WS_LCP) + (size_t)b * 8 * TP : (float*)(ws + WS_LCS) + (size_t)b * 8 * NKS;
                cumsum_block(lds, sA, pr ? TP : PAST, sB, pr ? TP : NKS, pr ? 16 : 8, dst);
            }
        }
        pg8::Gemm g{(const bf16_t*)(ws + WS_A2), (const bf16_t*)(ws + WS_WL), MT, 1536, 256, 256}; pg8::StaticOrder S; S.init(MT, 1536, G, blk);
        pg8::EpiLora E{(float*)(ws + WS_WDEC), (bf16_t*)(ws + WS_AG), a.in[14], a.in[16]}; pg8::gemm_phase<pg8::EpiLora, pg8::StaticOrder, true>(lds, g, S, E); } SEAM(4);
    if (IN(5)) {
        unsigned* ctl = (unsigned*)(ws + WS_CTL);
        if (blk < 32) {
            const int bh = blk, b = bh >> 3;
            sb_chain(a, lds, bh * NCH, NCH, b * TP, bh & 7, nullptr, a.out + O_STP + (size_t)bh * 4096, nullptr);
        } else {
            const int NSA = G - 32;
#define SA_ITEM_OF(q) ((q) < 64 ? 32 * NCH + (q) : (((q) - 64) & 31) * NCH + (((q) - 64) >> 5))
            int prev = -1; SaRegs cur, nxt; if (blk - 32 < SA_ITEMS) sa_load(a, SA_ITEM_OF(blk - 32), cur);
            for (int q = blk - 32; q < SA_ITEMS; q += NSA) { if (q + NSA < SA_ITEMS) sa_load(a, SA_ITEM_OF(q + NSA), nxt); sa_item(a, lds, SA_ITEM_OF(q), cur, prev); prev = SA_ITEM_OF(q); cur = nxt; }
            if (prev >= 0) { asm volatile("s_waitcnt vmcnt(0)" ::: "memory"); __syncthreads();
                if (threadIdx.x == 0) __hip_atomic_store(ctl + 1024 + prev, 1u, __ATOMIC_RELAXED, __HIP_MEMORY_SCOPE_AGENT); }
#undef SA_ITEM_OF
            if (blk < 96) { const int bh = blk - 32, b = bh >> 3;
                sb_chain(a, lds, 32 * NCH + bh, 1, MP + b * TS, bh & 7, a.in[5] + (size_t)bh * 4096, a.out + O_STS + (size_t)bh * 4096, a.in[6] + (size_t)b * RC); }
        }
        phase5(a, lds);
        GRID_BAR();
        {
            const pg8::RowSet rs{1, 0}; const int pool = G, rank = blk; unsigned* bw = ctl + 808;
            float* X1b = a.out + O_Y; bf16_t* H2b = (bf16_t*)(ws + WS_XN); bf16_t* ACTb = (bf16_t*)(ws + WS_ACT);
            phase6(a, rs, rank, pool, 0);
            GRID_BAR();
            { pg8::Gemm g{(const bf16_t*)(ws + WS_PF), (const bf16_t*)(ws + WS_WO), MT, 1024, 1024, RC}; pg8::MapOrder S{rs, 4, pool, rank, 1};
              pg8::EpiResid E{a.in[0], a.in[1], nullptr, X1b, nullptr, mod + 2048}; pg8::gemm_phase<pg8::EpiResid, pg8::MapOrder, true>(lds, g, S, E); }
            GRID_BAR();
            norm2_rows(a, rs, rank, pool, X1b, H2b, mod, 0);
            GRID_BAR();
            { pg8::Gemm g{H2b, (const bf16_t*)(ws + WS_WGU), MT, 2 * DFF, 1024, 1024}; pg8::MapOrder S{rs, 22, pool, rank, 0};
              pg8::EpiSwiglu E{ACTb}; pg8::gemm_phase<pg8::EpiSwiglu, pg8::MapOrder, true>(lds, g, S, E); }
            GRID_BAR();
            { pg8::Gemm g{ACTb, (const bf16_t*)(ws + WS_WD), MT, 1024, DFF, DFF}; pg8::MapOrder S{rs, 4, pool, rank, 0};
              pg8::EpiResid E{X1b, X1b + (size_t)MP * DM, nullptr, X1b, nullptr, mod + 5120}; pg8::gemm_phase<pg8::EpiResid, pg8::MapOrder, true>(lds, g, S, E); }
        }
    }
#undef IN
#undef SEAM
}

#ifndef MK_N_LAUNCHES
#define MK_N_LAUNCHES 1
#endif
extern "C" void kernel_launch(void* const* d_in, const int* in_sizes, int n_in, void* d_out, int out_size, void* d_ws, size_t ws_size, hipStream_t stream) {
    static int grid = 0;
    if (grid == 0) {
        if (n_in != 32 || ws_size < WS_END) { fprintf(stderr, "kernel_launch: unexpected n_in %d / ws %zu\n", n_in, ws_size); grid = -1; return; }
        int dev = 0, cus = 0, per_cu = 0;
        hipGetDevice(&dev); hipDeviceGetAttribute(&cus, hipDeviceAttributeMultiprocessorCount, dev);
        hipFuncSetAttribute((const void*)mk_fwd, hipFuncAttributeMaxDynamicSharedMemorySize, LDS_BYTES);
        hipOccupancyMaxActiveBlocksPerMultiprocessor(&per_cu, (const void*)mk_fwd, 512, LDS_BYTES);
        (void)hipGetLastError();
        if (per_cu < 1) per_cu = 1;
        grid = cus;
        if (grid < 1) grid = 256;
    }
    if (grid < 0) return;
    hipMemsetAsync((char*)d_ws + WS_CTL, 0, 40960, stream);
    Args a{};
    for (int i = 0; i < 32; ++i) a.in[i] = (const float*)d_in[i];
    a.out = (float*)d_out; a.ws = (unsigned char*)d_ws;
    if (MK_N_LAUNCHES == 1) {
        a.ph_lo = 0; a.ph_hi = NPHASE; void* args[] = {&a};
        hipError_t e = hipLaunchCooperativeKernel((const void*)mk_fwd, dim3(grid), dim3(512), args, LDS_BYTES, stream);
        if (e != hipSuccess) fprintf(stderr, "cooperative launch failed: %s (grid %d)\n", hipGetErrorString(e), grid);
    } else {
        for (int p = 0; p < NPHASE; ++p) { a.ph_lo = p; a.ph_hi = p + 1; hipLaunchKernelGGL(mk_fwd, dim3(grid), dim3(512), LDS_BYTES, stream, a); }
    }
}
```

```cpp
#include <hip/hip_runtime.h>
#include <hip/hip_cooperative_groups.h>
#include <cstdint>
#include <cstdio>
namespace cg = cooperative_groups;

#define LAS __attribute__((address_space(3)))
typedef unsigned short bf16_t;
typedef short bf16x8 __attribute__((ext_vector_type(8)));
typedef float f32x4 __attribute__((ext_vector_type(4)));
typedef float f32x2 __attribute__((ext_vector_type(2)));
typedef float f32x16 __attribute__((ext_vector_type(16)));
typedef unsigned u32x4 __attribute__((ext_vector_type(4)));
typedef unsigned u32x2 __attribute__((ext_vector_type(2)));
typedef short v4i16_t __attribute__((ext_vector_type(4)));

#ifndef REP_GEMM
#define REP_GEMM 1
#endif
#ifndef REP_SCAN
#define REP_SCAN 1
#endif
#ifndef REP_ROWS
#define REP_ROWS 1
#endif
constexpr int DM = 1024, TP = 8192, BP = 4, BS = 8, TS = 64, PAST = 2048, NKS = PAST + TS;
constexpr int MP = BP * TP, MS = BS * TS, MT = MP + MS;
constexpr int RC = 1792, INC = 3336, NPAD = 3584, DFF = 2816;
constexpr float LOG2E = 1.4426950408889634f;
constexpr float QSCALE = 0.125f * LOG2E;
constexpr size_t O_Y = 0, O_STP = 34078720, O_SHP = 34209792, O_KP = 34216960, O_VP = 50994176, O_LFP = 67771392,
                 O_STS = 68033536, O_SHS = 68295680, O_KS = 68310016, O_VS = 68572160, O_LFS = 68834304;
constexpr size_t KiB = 1024, MiB = 1u << 20;
constexpr size_t WS_CTL = 0, WS_MOD = 1 * MiB, WS_RK = 2 * MiB, WS_LCP = 3 * MiB + 256 * KiB, WS_LCS = 4 * MiB + 512 * KiB;
constexpr size_t WS_WIN = 6 * MiB, WS_WO = 13 * MiB, WS_WGU = 15 * MiB, WS_WD = 26 * MiB, WS_WL = 31 * MiB + 512 * KiB;
constexpr size_t WS_XN = 33 * MiB, WS_PR = 98 * MiB, WS_A2 = 211 * MiB + 768 * KiB, WS_PF = 228 * MiB;
constexpr size_t WS_WDEC = 341 * MiB + 768 * KiB, WS_AG = 406 * MiB + 768 * KiB, WS_KS = 471 * MiB + 768 * KiB, WS_VS = 488 * MiB + 256 * KiB;
constexpr size_t WS_END = 509 * MiB + 768 * KiB;
constexpr size_t WS_Y = WS_XN, WS_X1 = WS_PR, WS_ACT = WS_PF;
constexpr size_t WS_ACTG = WS_KS, WS_H2G = WS_A2;
static_assert(WS_PR + (size_t)MT * RC * 2 == WS_A2 && WS_A2 + (size_t)MT * 256 * 2 == WS_PF && WS_PF + (size_t)MT * RC * 2 == WS_WDEC, "ws map");
static_assert(WS_WDEC + (size_t)MT * 512 * 4 == WS_AG && WS_AG + (size_t)MT * 1024 * 2 == WS_KS && WS_X1 + (size_t)MT * 1024 * 4 == WS_PF, "ws map");
static_assert(WS_ACT + (size_t)MT * DFF * 2 == WS_AG && WS_XN + (size_t)MT * 1024 * 2 == WS_PR, "ws map");
constexpr int LDS_BYTES = 147456;

__device__ __forceinline__ float bflo(unsigned u) { return __uint_as_float(u << 16); }
__device__ __forceinline__ float bfhi(unsigned u) { return __uint_as_float(u & 0xffff0000u); }
__device__ __forceinline__ float bf1(bf16_t b) { return __uint_as_float(((unsigned)b) << 16); }
__device__ __forceinline__ unsigned f2bf(float f) { unsigned u = __float_as_uint(f); return (u + 0x7fffu + ((u >> 16) & 1u)) >> 16; }
__device__ __forceinline__ unsigned pk2(float lo, float hi) { return f2bf(lo) | (f2bf(hi) << 16); }
__device__ __forceinline__ void unpack8(u32x4 u, float* f) { f[0] = bflo(u.x); f[1] = bfhi(u.x); f[2] = bflo(u.y); f[3] = bfhi(u.y); f[4] = bflo(u.z); f[5] = bfhi(u.z); f[6] = bflo(u.w); f[7] = bfhi(u.w); }
__device__ __forceinline__ u32x4 pack8(const float* f) { u32x4 o; o.x = pk2(f[0], f[1]); o.y = pk2(f[2], f[3]); o.z = pk2(f[4], f[5]); o.w = pk2(f[6], f[7]); return o; }
__device__ __forceinline__ float wave_sum(float v) {
#pragma unroll
    for (int o = 1; o < 64; o <<= 1) v += __shfl_xor(v, o);
    return v;
}
__device__ __forceinline__ float sigmoidf_(float x) { return 1.0f / (1.0f + __expf(-x)); }
template <int CTRL> __device__ __forceinline__ float dppf(float x) { return __builtin_bit_cast(float, __builtin_amdgcn_update_dpp(0, __builtin_bit_cast(int, x), CTRL, 0xf, 0xf, true)); }
__device__ __forceinline__ float sum8(float v) { v += dppf<0xB1>(v); v += dppf<0x4E>(v); v += dppf<0x141>(v); return v; }
__device__ __forceinline__ float allsum16(float v) {
    v += dppf<0xB1>(v); v += dppf<0x4E>(v); v += dppf<0x141>(v); v += dppf<0x140>(v); return v;
}
__device__ __forceinline__ int batch_of_row(int m) { return m < MP ? (m >> 13) : 4 + ((m - MP) >> 6); }


__device__ __forceinline__ void cbar(unsigned* ctr, unsigned target) {
    asm volatile("s_waitcnt vmcnt(0)" ::: "memory");
    __syncthreads();
    if (threadIdx.x == 0) {
        __builtin_amdgcn_fence(__ATOMIC_RELEASE, "agent");
        asm volatile("s_waitcnt vmcnt(0)" ::: "memory");
        __hip_atomic_fetch_add(ctr, 1u, __ATOMIC_RELAXED, __HIP_MEMORY_SCOPE_AGENT);
        while (__hip_atomic_load(ctr, __ATOMIC_RELAXED, __HIP_MEMORY_SCOPE_AGENT) < target) __builtin_amdgcn_s_sleep(2);
        __builtin_amdgcn_fence(__ATOMIC_ACQUIRE, "agent");
        asm volatile("s_waitcnt vmcnt(0)" ::: "memory");
    }
    __syncthreads();
}

#define XB_TMO      128
#define XB_XCNT(j)  (256  + 64 * (j))
#define XB_XSUB(j)  (1280 + 64 * (j))
#define XB_XGEN(j)  (2304 + 64 * (j))
#define XB_TOP      3328
#define XB_TOPGEN   3392
#define XCD_BAR_WORDS 3456
#define XB_SPIN_CAP (1u << 22)
__device__ __forceinline__ unsigned xb_ld(unsigned* p)              { return __hip_atomic_load(p, __ATOMIC_RELAXED, __HIP_MEMORY_SCOPE_AGENT); }
__device__ __forceinline__ unsigned xb_add(unsigned* p, unsigned v) { return __hip_atomic_fetch_add(p, v, __ATOMIC_RELAXED, __HIP_MEMORY_SCOPE_AGENT); }
__device__ __forceinline__ unsigned xb_xcc_id() { return (unsigned)__builtin_amdgcn_s_getreg((3 << 11) | 20) & 0xFu; }
#define XB_SPIN(cond, bar) do { unsigned _sp = 0; while (cond) { __builtin_amdgcn_s_sleep(1); \
    if ((++_sp & 255u) == 0u) { if (xb_ld(&(bar)[XB_TMO])) break; if (_sp > XB_SPIN_CAP) { atomicAdd(&(bar)[XB_TMO], 1u); break; } } } } while (0)
struct XcdBarrier { unsigned* bar; unsigned x; volatile LAS unsigned* st; };
__device__ __forceinline__ XcdBarrier xcd_barrier_post(unsigned* bar, volatile LAS unsigned* st) {
    XcdBarrier b; b.bar = bar; b.x = xb_xcc_id(); b.st = st;
    if (threadIdx.x == 0) (void)xb_add(&bar[XB_XCNT(b.x)], 1u);
    return b;
}
__device__ __forceinline__ void xcd_barrier_complete(unsigned* bar, unsigned x, unsigned& nloc, unsigned& nx) {
    const unsigned Gn = gridDim.x * gridDim.y * gridDim.z;
    unsigned sum, cnt, mine, sp = 0u;
    for (;;) {
        sum = 0u; cnt = 0u; mine = 0u;
#pragma unroll
        for (unsigned j = 0; j < 16; ++j) { const unsigned c = xb_ld(&bar[XB_XCNT(j)]); sum += c; cnt += (c > 0u) ? 1u : 0u; mine = (j == x) ? c : mine; }
        if (sum == Gn) break;
        __builtin_amdgcn_s_sleep(1);
        if ((++sp & 255u) == 0u) { if (xb_ld(&bar[XB_TMO])) break; if (sp > XB_SPIN_CAP) { atomicAdd(&bar[XB_TMO], 1u); break; } }
    }
    nloc = mine > 0u ? mine : 1u; nx = cnt > 0u ? cnt : 1u;
}
__device__ __forceinline__ void xcd_barrier(const XcdBarrier& b, bool first) {
    asm volatile("s_waitcnt vmcnt(0)" ::: "memory");
    __syncthreads();
    if (threadIdx.x == 0) {
        unsigned* bar = b.bar;
        __builtin_amdgcn_s_waitcnt(0);
        unsigned nloc = first ? 0u : b.st[0], nx = first ? 0u : b.st[1];
        if (first) (void)xb_add(&bar[XB_XCNT(b.x)], 1u);
        if (nloc == 0u) { xcd_barrier_complete(bar, b.x, nloc, nx); b.st[0] = nloc; b.st[1] = nx; }
        const unsigned old = xb_add(&bar[XB_XSUB(b.x)], 1u);
        const unsigned gen = old / nloc;
        if (old + 1u == (gen + 1u) * nloc) {
            __builtin_amdgcn_fence(__ATOMIC_RELEASE, "agent");
            asm volatile("s_waitcnt vmcnt(0)" ::: "memory");
            const unsigned og = xb_add(&bar[XB_TOP], 1u);
            const unsigned tg = og / nx;
            if (og + 1u == (tg + 1u) * nx) xb_add(&bar[XB_TOPGEN], 1u);
            else XB_SPIN(xb_ld(&bar[XB_TOPGEN]) == tg, bar);
            __builtin_amdgcn_fence(__ATOMIC_ACQUIRE, "agent");
            xb_add(&bar[XB_XGEN(b.x)], 1u);
            asm volatile("s_waitcnt vmcnt(0)" ::: "memory");
        } else {
            XB_SPIN(xb_ld(&bar[XB_XGEN(b.x)]) == gen, bar);
            __builtin_amdgcn_fence(__ATOMIC_ACQUIRE, "agent");
            asm volatile("s_waitcnt vmcnt(0)" ::: "memory");
        }
    }
    __syncthreads();
}

namespace pg8 {
constexpr int BM = 256, BK = 64, HALF = 128, HTB = HALF * BK * 2, STAGE_BYTES = 8 * HTB, NXCD = 8, WGM = 8;
__host__ __device__ __forceinline__ int lds_byte(int r, int c) { const int st = (r >> 4) * 2 + (c >> 5), rr = r & 15, cc = c & 31, ob = rr * 64 + cc * 2; return st * 1024 + (ob ^ (((ob >> 9) & 1) << 5)); }
__host__ __device__ __forceinline__ void stage_rc(int b, int& R, int& C) { const int st = b / 1024, sb = b % 1024, swz = sb ^ (((sb >> 9) & 1) << 5); R = (st >> 1) * 16 + swz / 64; C = (st & 1) * 32 + (swz % 64) / 2; }
__host__ __device__ __forceinline__ int perm32(int rho) { const int n = rho >> 4, i = rho & 15; return 8 * (i >> 2) + 4 * n + (i & 3); }
struct Unit { int pm, pn, pg, pb; };
struct Gemm { const bf16_t* A; const bf16_t* Bt; int M, N, K, lda; };
struct StaticOrder {
    int nM, nN, nwg, G, c;
    __device__ void init(int M, int N, int G_, int c_) { nM = M / BM; nN = N / BM; nwg = nM * nN; G = G_; c = c_; }
    __device__ bool next(int i, Unit& u) const {
        const long L = (long)i * G + c; if (L >= (long)nwg * REP_GEMM) return false;
        int wgid = (int)(L % nwg); { const int q = nwg / NXCD, r = nwg % NXCD, xcd = wgid % NXCD, off = wgid / NXCD; wgid = (xcd < r ? xcd * (q + 1) : r * (q + 1) + (xcd - r) * q) + off; }
        const int nig = WGM * nN, gid = wgid / nig, fm = gid * WGM, gsz = (nM - fm) < WGM ? (nM - fm) : WGM;
        u.pm = fm + ((wgid % nig) % gsz); u.pn = (wgid % nig) / gsz; u.pg = u.pm; u.pb = u.pm; return true;
    }
};

struct RowSet {
    int rest, g;
    __device__ __forceinline__ int ntiles() const { return MT / 256; }
    __device__ __forceinline__ int nrows() const { return MT; }
    __device__ __forceinline__ int gtile(int rt) const { return rt; }
    __device__ __forceinline__ int grow(int r) const { return r; }
    __device__ __forceinline__ int brow(int r) const { return r; }
};
struct MapOrder {
    RowSet rs; int nN, pool, rank, a_global;
    __device__ bool next(int i, Unit& u) const {
        const int L = i * pool + rank; if (L >= rs.ntiles() * nN) return false;
        const int rt = L / nN; u.pn = L % nN; u.pg = rs.gtile(rt); u.pb = u.pg; u.pm = a_global ? u.pg : u.pb; return true;
    }
};
__device__ __forceinline__ unsigned cvt_pk_bf16(float lo, float hi) { unsigned r; asm volatile("v_cvt_pk_bf16_f32 %0, %1, %2" : "=v"(r) : "v"(lo), "v"(hi)); return r; }

struct EpiProj {
    static constexpr bool PERM = true;
    bf16_t* PR; bf16_t* PF;
    __device__ __forceinline__ void operator()(const f32x4 (&acc)[2][2][4][2], const Unit& u, int wr, int wc, int fr, int fq) const {
        int colt = u.pn * BM; bf16_t* base = PR; if (colt >= RC) { base = PF; colt -= RC; }
        const int row0 = u.pm * BM + wr * 64 + fr, col0 = colt + wc * 32 + 8 * fq;
#pragma unroll
        for (int ai = 0; ai < 2; ++ai)
#pragma unroll
            for (int m = 0; m < 4; ++m) { bf16_t* rowp = base + (size_t)(row0 + ai * HALF + m * 16) * RC + col0;
#pragma unroll
                for (int bj = 0; bj < 2; ++bj) { const f32x4 v0 = acc[ai][bj][m][0], v1 = acc[ai][bj][m][1]; u32x4 w;
                    w.x = cvt_pk_bf16(v0[0], v0[1]); w.y = cvt_pk_bf16(v0[2], v0[3]); w.z = cvt_pk_bf16(v1[0], v1[1]); w.w = cvt_pk_bf16(v1[2], v1[3]);
                    *(u32x4*)(rowp + bj * HALF) = w; } }
    }
};
struct EpiLora {
    static constexpr bool PERM = false;
    float* Wdec; bf16_t* AG; const float* w0; const float* a0;
    __device__ __forceinline__ void operator()(const f32x4 (&acc)[2][2][4][2], const Unit& u, int wr, int wc, int fr, int fq) const {
        const int type = u.pn >> 1, cbase = (u.pn & 1) * BM + wc * 32 + 4 * fq, row0 = u.pm * BM + wr * 64 + fr;
#pragma unroll
        for (int bj = 0; bj < 2; ++bj)
#pragma unroll
            for (int n = 0; n < 2; ++n) { const int ch = cbase + bj * HALF + n * 16;
                f32x4 bias = (f32x4){0.f, 0.f, 0.f, 0.f};
                if (type == 0) bias = *(const f32x4*)(w0 + ch); else if (type == 1) bias = *(const f32x4*)(a0 + ch);
#pragma unroll
                for (int ai = 0; ai < 2; ++ai)
#pragma unroll
                    for (int m = 0; m < 4; ++m) { const size_t row = (size_t)(row0 + ai * HALF + m * 16); f32x4 v = acc[ai][bj][m][n] + bias;
                        if (type == 0) { f32x4 o;
#pragma unroll
                            for (int j = 0; j < 4; ++j) o[j] = __expf(-0.6065306597126334f * sigmoidf_(v[j]));
                            *(f32x4*)(Wdec + row * 512 + ch) = o; }
                        else { if (type == 1) {
#pragma unroll
                                for (int j = 0; j < 4; ++j) v[j] = sigmoidf_(v[j]); }
                            u32x2 w; w.x = cvt_pk_bf16(v[0], v[1]); w.y = cvt_pk_bf16(v[2], v[3]);
                            *(u32x2*)(AG + row * 1024 + (type == 2 ? 512 : 0) + ch) = w; } } }
    }
};
struct EpiResid {
    static constexpr bool PERM = false;
    const float* base_p; const float* base_s; const float* base_buf; float* out_final; float* out_buf; const float* gate;
    __device__ __forceinline__ void operator()(const f32x4 (&acc)[2][2][4][2], const Unit& u, int wr, int wc, int fr, int fq) const {
        const int col0 = u.pn * BM + wc * 32 + 4 * fq;
#pragma unroll
        for (int ai = 0; ai < 2; ++ai)
#pragma unroll
            for (int m = 0; m < 4; ++m) { const int rl = ai * HALF + wr * 64 + m * 16 + fr, row = u.pg * BM + rl, rowb = u.pb * BM + rl;
                const float* bp = (base_buf ? base_buf + (size_t)rowb * DM : (row < MP ? base_p + (size_t)row * DM : base_s + (size_t)(row - MP) * DM)) + col0;
                const float* gp = gate + (size_t)batch_of_row(row) * 6144 + col0; float* op = (out_final ? out_final + (size_t)row * DM : out_buf + (size_t)rowb * DM) + col0;
#pragma unroll
                for (int bj = 0; bj < 2; ++bj)
#pragma unroll
                    for (int n = 0; n < 2; ++n) { const int o = bj * HALF + n * 16; const f32x4 b = *(const f32x4*)(bp + o), g = *(const f32x4*)(gp + o);
                        *(f32x4*)(op + o) = b + g * acc[ai][bj][m][n]; } }
    }
};
struct EpiSwiglu {
    static constexpr bool PERM = true;
    bf16_t* ACT;
    __device__ __forceinline__ void operator()(const f32x4 (&acc)[2][2][4][2], const Unit& u, int wr, int wc, int fr, int fq) const {
        const int row0 = u.pb * BM + wr * 64 + fr, col0 = u.pn * HALF + wc * 32 + 8 * fq;
#pragma unroll
        for (int ai = 0; ai < 2; ++ai)
#pragma unroll
            for (int m = 0; m < 4; ++m) { float r[8];
#pragma unroll
                for (int n = 0; n < 2; ++n)
#pragma unroll
                    for (int j = 0; j < 4; ++j) { const float g = acc[ai][0][m][n][j], up = acc[ai][1][m][n][j]; r[n * 4 + j] = g * __builtin_amdgcn_rcpf(1.0f + __expf(-g)) * up; }
                u32x4 w; w.x = cvt_pk_bf16(r[0], r[1]); w.y = cvt_pk_bf16(r[2], r[3]); w.z = cvt_pk_bf16(r[4], r[5]); w.w = cvt_pk_bf16(r[6], r[7]);
                *(u32x4*)(ACT + (size_t)(row0 + ai * HALF + m * 16) * DFF + col0) = w; }
    }
};

template <class Epi, class Sched, bool ALIGN_EPI>
__device__ __forceinline__ void gemm_phase(LAS unsigned char* lds, const Gemm g, const Sched& S, const Epi& E, int opq = 0) {
    const int tid = threadIdx.x + opq, wid = __builtin_amdgcn_readfirstlane(tid >> 6), lane = tid & 63, wr = wid >> 2, wc = wid & 3, fr = lane & 15, fq = lane >> 4;
    const int K = g.K, nt = K / BK, lda = g.lda;
    unsigned voffA[2], voffB[2];
#pragma unroll
    for (int i = 0; i < 2; ++i) { int R, C; stage_rc(tid * 16 + i * 8192, R, C); const int Rb = Epi::PERM ? ((R & ~31) + perm32(R & 31)) : R;
        voffA[i] = (unsigned)(R * lda + C) * 2u; voffB[i] = (unsigned)(Rb * K + C) * 2u; }
    const size_t kstep = (size_t)(BK * 2);
    const size_t hstepA = (size_t)HALF * lda * 2, hstepB = (size_t)HALF * K * 2;
    const size_t tstepA = 2 * hstepA, tstepB = 2 * hstepB;
    const unsigned ldsw = (unsigned)wid * 1024u;
    const int aoff = lds_byte(wr * 64 + fr, fq * 8), boff = lds_byte(wc * 32 + fr, fq * 8);
#define PG8_SA(b, h) (((b) * 2 + (h)) * HTB)
#define PG8_SB(b, h) ((4 + (b) * 2 + (h)) * HTB)
#define PG8_STAGE(bufoff, gbase, voff) do { _Pragma("unroll") for (int _i = 0; _i < 2; ++_i) \
        __builtin_amdgcn_global_load_lds((const unsigned*)((const char*)(gbase) + (voff)[_i]), (LAS unsigned*)(lds + (bufoff) + ldsw + _i * 8192), 16, 0, 0); } while (0)
#define PG8_LDA(dst, b, h) do { _Pragma("unroll") for (int m = 0; m < 4; ++m) _Pragma("unroll") for (int k = 0; k < 2; ++k) dst[m][k] = *(const LAS bf16x8*)(lds + PG8_SA(b, h) + aoff + m * 2048 + k * 1024); } while (0)
#define PG8_LDB(dst, b, h) do { _Pragma("unroll") for (int n = 0; n < 2; ++n) _Pragma("unroll") for (int k = 0; k < 2; ++k) dst[n][k] = *(const LAS bf16x8*)(lds + PG8_SB(b, h) + boff + n * 2048 + k * 1024); } while (0)
#define PG8_MMA(ai, bj, At, Bt) do { __builtin_amdgcn_s_setprio(1); _Pragma("unroll") for (int m = 0; m < 4; ++m) _Pragma("unroll") for (int n = 0; n < 2; ++n) _Pragma("unroll") for (int k = 0; k < 2; ++k) \
        acc[ai][bj][m][n] = __builtin_amdgcn_mfma_f32_16x16x32_bf16(Bt[n][k], At[m][k], acc[ai][bj][m][n], 0, 0, 0); __builtin_amdgcn_s_setprio(0); } while (0)
#define PG8_WAIT_V(n) asm volatile("s_waitcnt vmcnt(" #n ")" ::: "memory")
#define PG8_WAIT_L(n) asm volatile("s_waitcnt lgkmcnt(" #n ")" ::: "memory")
#define PG8_BAR __builtin_amdgcn_s_barrier()
#define PG8_SCHED __builtin_amdgcn_sched_barrier(0)
    Unit cur, nxt; int ui = 0;
    if (!S.next(0, cur)) return;
    f32x4 acc[2][2][4][2];
#pragma unroll
    for (int a = 0; a < 2; ++a)
#pragma unroll
        for (int b = 0; b < 2; ++b)
#pragma unroll
            for (int m = 0; m < 4; ++m)
#pragma unroll
                for (int n = 0; n < 2; ++n) acc[a][b][m][n] = (f32x4){0.f, 0.f, 0.f, 0.f};
    bf16x8 At[4][2], B0[2][2], B1[2][2];
    const char* cA = (const char*)g.A + (size_t)cur.pm * tstepA; const char* cB = (const char*)g.Bt + (size_t)cur.pn * tstepB;
    PG8_STAGE(PG8_SB(0, 0), cB, voffB); PG8_STAGE(PG8_SB(0, 1), cB + hstepB, voffB); PG8_STAGE(PG8_SA(0, 0), cA, voffA); PG8_STAGE(PG8_SA(0, 1), cA + hstepA, voffA);
    if (wr == 1) PG8_BAR;
    PG8_WAIT_V(2); PG8_BAR;
    PG8_STAGE(PG8_SB(1, 0), cB + kstep, voffB); PG8_STAGE(PG8_SA(1, 0), cA + kstep, voffA); PG8_STAGE(PG8_SB(1, 1), cB + hstepB + kstep, voffB);
    PG8_WAIT_V(6); PG8_BAR;
    for (;;) {
        const bool has_next = S.next(ui + 1, nxt);
        const char* nA = has_next ? (const char*)g.A + (size_t)nxt.pm * tstepA : cA; const char* nB = has_next ? (const char*)g.Bt + (size_t)nxt.pn * tstepB : cB;
        for (int t = 0; t < nt; t += 2) {
            const bool last = (t == nt - 2);
            const char* a1 = cA + (size_t)(t + 1) * kstep;
            const char* a2 = last ? nA : cA + (size_t)(t + 2) * kstep; const char* b2 = last ? nB : cB + (size_t)(t + 2) * kstep;
            const char* a3 = a2 + kstep; const char* b3 = b2 + kstep;
            PG8_LDB(B0, 0, 0); PG8_LDB(B1, 0, 1); PG8_SCHED; PG8_LDA(At, 0, 0); PG8_STAGE(PG8_SA(1, 1), a1 + hstepA, voffA);
            PG8_WAIT_V(8); PG8_WAIT_L(0); PG8_BAR; PG8_MMA(0, 0, At, B0); PG8_MMA(0, 1, At, B1); PG8_BAR; PG8_SCHED;
            PG8_LDA(At, 0, 1); PG8_STAGE(PG8_SB(0, 0), b2, voffB); PG8_STAGE(PG8_SB(0, 1), b2 + hstepB, voffB); PG8_STAGE(PG8_SA(0, 0), a2, voffA);
            PG8_WAIT_V(8); PG8_WAIT_L(0); PG8_BAR; PG8_MMA(1, 0, At, B0); PG8_MMA(1, 1, At, B1); PG8_BAR; PG8_SCHED;
            PG8_LDB(B0, 1, 0); PG8_LDB(B1, 1, 1); PG8_SCHED; PG8_LDA(At, 1, 0); PG8_STAGE(PG8_SA(0, 1), a2 + hstepA, voffA);
            PG8_WAIT_V(8); PG8_WAIT_L(0); PG8_BAR; PG8_MMA(0, 0, At, B0); PG8_MMA(0, 1, At, B1); PG8_BAR; PG8_SCHED;
            PG8_LDA(At, 1, 1); PG8_STAGE(PG8_SB(1, 0), b3, voffB); PG8_STAGE(PG8_SB(1, 1), b3 + hstepB, voffB); PG8_STAGE(PG8_SA(1, 0), a3, voffA);
            PG8_WAIT_V(8); PG8_WAIT_L(0); PG8_BAR; PG8_MMA(1, 0, At, B0); PG8_MMA(1, 1, At, B1); PG8_BAR; PG8_SCHED;
        }
        if constexpr (ALIGN_EPI) { if (wr == 0) PG8_BAR; }
        E(acc, cur, wr, wc, fr, fq);
        if (!has_next) break;
#pragma unroll
        for (int a = 0; a < 2; ++a)
#pragma unroll
            for (int b = 0; b < 2; ++b)
#pragma unroll
                for (int m = 0; m < 4; ++m)
#pragma unroll
                    for (int n = 0; n < 2; ++n) acc[a][b][m][n] = (f32x4){0.f, 0.f, 0.f, 0.f};
        cur = nxt; cA = nA; cB = nB; ++ui;
        if constexpr (ALIGN_EPI) { if (wr == 1) PG8_BAR; }
    }
    PG8_WAIT_V(0);
    if constexpr (!ALIGN_EPI) { if (wr == 0) PG8_BAR; }
    PG8_BAR;
#undef PG8_SA
#undef PG8_SB
#undef PG8_STAGE
#undef PG8_LDA
#undef PG8_LDB
#undef PG8_MMA
#undef PG8_WAIT_V
#undef PG8_WAIT_L
#undef PG8_BAR
#undef PG8_SCHED
}
}

struct Args { const float* in[32]; float* out; unsigned char* ws; int ph_lo, ph_hi; };

struct SrcPlain { const float* W; int ld, nvalid; __device__ __forceinline__ float operator()(int k, int n) const { return n < nvalid ? W[(size_t)k * ld + n] : 0.f; } };
struct SrcRot { const float* W; __device__ __forceinline__ float operator()(int k, int n) const { return W[(size_t)((k + 512) & 1023) * 1024 + n]; } };
struct SrcLora { const float* wd; const float* wa; const float* wg;
    __device__ __forceinline__ float operator()(int k, int n) const {
        if (n < 512) return k < 64 ? wd[k * 512 + n] : 0.f;
        if (n < 1024) return (k >= 64 && k < 128) ? wa[(k - 64) * 512 + (n - 512)] : 0.f;
        return k >= 128 ? wg[(k - 128) * 512 + (n - 1024)] : 0.f; } };
struct DstId { __device__ __forceinline__ int operator()(int n) const { return n; } };
struct DstGU { int add; __device__ __forceinline__ int operator()(int n) const { return (n >> 7) * 256 + (n & 127) + add; } };
template <class SrcF, class DstF>
__device__ __forceinline__ void tr_item(const SrcF& src, const DstF& drow, bf16_t* WT, int ldt, int k0, int n0, LAS float* scr, int lane) {
#pragma unroll 8
    for (int i = 0; i < 32; ++i) { const int kk = 2 * i + (lane >> 5); scr[kk * 33 + (lane & 31)] = src(k0 + kk, n0 + (lane & 31)); }
    asm volatile("s_waitcnt lgkmcnt(0)" ::: "memory");
    const int c = lane & 7;
#pragma unroll
    for (int j = 0; j < 4; ++j) { const int n = (lane >> 3) + 8 * j; const LAS float* s = scr + (8 * c) * 33 + n;
        u32x4 o; o.x = pk2(s[0 * 33], s[1 * 33]); o.y = pk2(s[2 * 33], s[3 * 33]); o.z = pk2(s[4 * 33], s[5 * 33]); o.w = pk2(s[6 * 33], s[7 * 33]);
        *(u32x4*)(WT + (size_t)drow(n0 + n) * ldt + k0 + 8 * c) = o; }
    asm volatile("s_waitcnt lgkmcnt(0)" ::: "memory");
}

__device__ __forceinline__ void phase0(const Args& a, LAS unsigned char* lds) {
    const int tid = threadIdx.x, lane = tid & 63, wid = tid >> 6, blk = blockIdx.x, G = gridDim.x;
    unsigned char* ws = a.ws;
    if (blk < 96) {
        LAS float* sc = (LAS float*)lds;
        LAS float* red = (LAS float*)(lds + 49152);
        for (int i = tid; i < 12 * 1024; i += 512) { const int r = i >> 10, k = i & 1023; const float c = r < 4 ? a.in[7][r * 1024 + k] : a.in[8][(r - 4) * 1024 + k]; sc[k * 12 + r] = c * sigmoidf_(c); }
        __syncthreads();
        float acc[12];
#pragma unroll
        for (int r = 0; r < 12; ++r) acc[r] = 0.f;
        const float* wp = a.in[10] + (size_t)(wid * 128) * 6144 + blk * 64 + lane;
#pragma unroll 8
        for (int kk = 0; kk < 128; ++kk) { const float wv = wp[(size_t)kk * 6144]; const LAS f32x4* s = (const LAS f32x4*)(sc + (wid * 128 + kk) * 12);
            const f32x4 s0 = s[0], s1 = s[1], s2 = s[2];
            acc[0] += s0[0] * wv; acc[1] += s0[1] * wv; acc[2] += s0[2] * wv; acc[3] += s0[3] * wv; acc[4] += s1[0] * wv; acc[5] += s1[1] * wv;
            acc[6] += s1[2] * wv; acc[7] += s1[3] * wv; acc[8] += s2[0] * wv; acc[9] += s2[1] * wv; acc[10] += s2[2] * wv; acc[11] += s2[3] * wv; }
#pragma unroll
        for (int r = 0; r < 12; ++r) red[(wid * 12 + r) * 64 + lane] = acc[r];
        __syncthreads();
        float* mod = (float*)(ws + WS_MOD);
        for (int i = tid; i < 768; i += 512) { const int r = i >> 6, c = i & 63; float s = 0.f;
#pragma unroll
            for (int w = 0; w < 8; ++w) s += red[(w * 12 + r) * 64 + c];
            mod[r * 6144 + blk * 64 + c] = s + a.in[11][blk * 64 + c]; }
        __syncthreads();
    }
    {
        LAS float* scr = (LAS float*)(lds + wid * 16384);
        const int gw = blk * 8 + wid, NGW = G * 8;
        constexpr int I_IN = 16 * 112, I_O = 16 * 32, I_G = 16 * 88, I_D = 44 * 32, I_L = 4 * 48;
        constexpr int NITEMS = I_IN + I_O + 2 * I_G + I_D + I_L;
        for (int it = gw; it < NITEMS; it += NGW) {
            int r = it;
            if (r < I_IN) { tr_item(SrcPlain{a.in[12], INC, INC}, DstId{}, (bf16_t*)(ws + WS_WIN), 1024, (r / 112) * 64, (r % 112) * 32, scr, lane); continue; } r -= I_IN;
            if (r < I_O) { tr_item(SrcRot{a.in[27]}, DstId{}, (bf16_t*)(ws + WS_WO), 1024, (r / 32) * 64, (r % 32) * 32, scr, lane); continue; } r -= I_O;
            if (r < I_G) { tr_item(SrcPlain{a.in[29], DFF, DFF}, DstGU{0}, (bf16_t*)(ws + WS_WGU), 1024, (r / 88) * 64, (r % 88) * 32, scr, lane); continue; } r -= I_G;
            if (r < I_G) { tr_item(SrcPlain{a.in[30], DFF, DFF}, DstGU{128}, (bf16_t*)(ws + WS_WGU), 1024, (r / 88) * 64, (r % 88) * 32, scr, lane); continue; } r -= I_G;
            if (r < I_D) { tr_item(SrcPlain{a.in[31], 1024, 1024}, DstId{}, (bf16_t*)(ws + WS_WD), DFF, (r / 32) * 64, (r % 32) * 32, scr, lane); continue; } r -= I_D;
            tr_item(SrcLora{a.in[15], a.in[17], a.in[18]}, DstId{}, (bf16_t*)(ws + WS_WL), 256, (r / 48) * 64, (r % 48) * 32, scr, lane);
        }
    }
    {
        const int gt = blk * 512 + tid, NGT = G * 512;
        for (int gidx = gt; gidx < 2 * 1048576; gidx += NGT) {
            const int which = gidx >> 20, g8 = gidx & 1048575; const size_t e = (size_t)g8 * 8; const int b = (int)(e >> 20); const size_t rem = e & 1048575;
            const float* src = (which ? a.in[3] : a.in[2]) + e; const f32x4 v0 = *(const f32x4*)src, v1 = *(const f32x4*)(src + 4);
            u32x4 o; o.x = pk2(v0[0], v0[1]); o.y = pk2(v0[2], v0[3]); o.z = pk2(v1[0], v1[1]); o.w = pk2(v1[2], v1[3]);
            bf16_t* dst = (bf16_t*)(ws + (which ? WS_VS : WS_KS)) + (size_t)b * NKS * 512 + rem; *(u32x4*)dst = o;
        }
    }
}

__device__ __forceinline__ void norm_rows(const float* xp, const float* xs, const float* gvec, const float* mod, int sh_off, int sc_off, bf16_t* XN) {
    const int lane = threadIdx.x & 63, gw = blockIdx.x * 8 + (threadIdx.x >> 6), NGW = gridDim.x * 8;
    f32x4 nx[4];
    auto ldrow = [&](int m) { const float* xr = (m < MP ? xp + (size_t)m * DM : xs + (size_t)(m - MP) * DM);
#pragma unroll
        for (int j = 0; j < 4; ++j) nx[j] = *(const f32x4*)(xr + 4 * lane + 256 * j); };
    if (gw < MT) ldrow(gw);
    for (int m = gw; m < MT; m += NGW) {
        const float* mr = mod + (size_t)batch_of_row(m) * 6144;
        f32x4 v[4]; float s = 0.f;
#pragma unroll
        for (int j = 0; j < 4; ++j) { v[j] = nx[j]; s += (v[j][0] * v[j][0] + v[j][1] * v[j][1]) + (v[j][2] * v[j][2] + v[j][3] * v[j][3]); }
        if (m + NGW < MT) ldrow(m + NGW);
        const float rinv = rsqrtf(wave_sum(s) * (1.f / DM) + 1e-6f);
#pragma unroll
        for (int j = 0; j < 4; ++j) { const int c = 4 * lane + 256 * j; const f32x4 g = *(const f32x4*)(gvec + c), sc = *(const f32x4*)(mr + sc_off + c), sh = *(const f32x4*)(mr + sh_off + c);
            f32x4 o;
#pragma unroll
            for (int q = 0; q < 4; ++q) o[q] = v[j][q] * rinv * g[q] * (1.f + sc[q]) + sh[q];
            u32x2 w; w.x = pk2(o[0], o[1]); w.y = pk2(o[2], o[3]); *(u32x2*)(XN + (size_t)m * DM + c) = w; }
    }
}

__device__ __forceinline__ void phase3(const Args& a) {
    const int lane = threadIdx.x & 63, gw = blockIdx.x * 8 + (threadIdx.x >> 6), NGW = gridDim.x * 8;
    unsigned char* ws = a.ws;
    bf16_t* PR = (bf16_t*)(ws + WS_PR); bf16_t* PF = (bf16_t*)(ws + WS_PF); bf16_t* A2 = (bf16_t*)(ws + WS_A2);
    const float* mu = a.in[13];
    struct P3Regs { u32x2 pw, qw; u32x4 q, k, v; bf16_t fl; };
    P3Regs nx;
    auto ldrow = [&](int m) { const bf16_t* pr = PR + (size_t)m * RC; const bf16_t* pf = PF + (size_t)m * RC; const int c = 1536 + 4 * lane;
        nx.pw = *(const u32x2*)(pr + c); nx.qw = *(const u32x2*)(PR + (size_t)(m > 0 ? m - 1 : 0) * RC + c);
        nx.q = *(const u32x4*)(pf + 8 * lane); nx.k = *(const u32x4*)(pf + 512 + 8 * lane); nx.v = *(const u32x4*)(pf + 1024 + 8 * lane); nx.fl = pf[1536 + (lane & 7)]; };
    if (gw < MT) ldrow(gw);
    for (int m = gw; m < MT; m += NGW) {
        const bool samp = m >= MP; const int ml = samp ? m - MP : m; const int b = samp ? (ml >> 6) : (ml >> 13); const int t = samp ? (ml & 63) : (ml & 8191);
        const bf16_t* pr = PR + (size_t)m * RC; bf16_t* pf = PF + (size_t)m * RC;
        const P3Regs cu = nx;
        if (m + NGW < MT) ldrow(m + NGW);
        {
            const int c = 1536 + 4 * lane; const u32x2 pw = cu.pw; float p[4] = {bflo(pw.x), bfhi(pw.x), bflo(pw.y), bfhi(pw.y)}; float pp[4];
            if (t > 0) { const u32x2 qw = cu.qw; pp[0] = bflo(qw.x); pp[1] = bfhi(qw.x); pp[2] = bflo(qw.y); pp[3] = bfhi(qw.y); }
            else if (samp) { const f32x4 q = *(const f32x4*)(a.in[6] + (size_t)b * RC + c); pp[0] = q[0]; pp[1] = q[1]; pp[2] = q[2]; pp[3] = q[3]; }
            else { pp[0] = pp[1] = pp[2] = pp[3] = 0.f; }
            const f32x4 mv = *(const f32x4*)(mu + c); float z[4];
#pragma unroll
            for (int j = 0; j < 4; ++j) { const float zz = p[j] + (pp[j] - p[j]) * mv[j]; z[j] = lane < 16 ? tanhf(zz) : (lane < 32 ? zz : sigmoidf_(zz)); }
            u32x2 w; w.x = pk2(z[0], z[1]); w.y = pk2(z[2], z[3]); *(u32x2*)(A2 + (size_t)m * 256 + 4 * lane) = w;
        }
        {
            float q[8]; unpack8(cu.q, q); float ss = 0.f;
#pragma unroll
            for (int j = 0; j < 8; ++j) ss += q[j] * q[j];
            const float rinv = rsqrtf(sum8(ss) * (1.f / 64.f) + 1e-6f) * QSCALE; const float* g = a.in[24] + ((8 * lane) & 63);
#pragma unroll
            for (int j = 0; j < 8; ++j) q[j] = q[j] * rinv * g[j];
            *(u32x4*)(pf + 8 * lane) = pack8(q);
        }
        {
            float k[8]; unpack8(cu.k, k); float ss = 0.f;
#pragma unroll
            for (int j = 0; j < 8; ++j) ss += k[j] * k[j];
            const float rinv = rsqrtf(sum8(ss) * (1.f / 64.f) + 1e-6f); const float* g = a.in[25] + ((8 * lane) & 63);
#pragma unroll
            for (int j = 0; j < 8; ++j) k[j] = k[j] * rinv * g[j];
            const u32x4 kb = pack8(k); *(u32x4*)(pf + 512 + 8 * lane) = kb;
            float* ko = a.out + (samp ? O_KS : O_KP) + (size_t)ml * 512 + 8 * lane;
            *(f32x4*)ko = (f32x4){k[0], k[1], k[2], k[3]}; *(f32x4*)(ko + 4) = (f32x4){k[4], k[5], k[6], k[7]};
            if (samp) *(u32x4*)((bf16_t*)(ws + WS_KS) + ((size_t)b * NKS + PAST + t) * 512 + 8 * lane) = kb;
        }
        {
            const u32x4 vb = cu.v; float v[8]; unpack8(vb, v);
            float* vo = a.out + (samp ? O_VS : O_VP) + (size_t)ml * 512 + 8 * lane;
            *(f32x4*)vo = (f32x4){v[0], v[1], v[2], v[3]}; *(f32x4*)(vo + 4) = (f32x4){v[4], v[5], v[6], v[7]};
            if (samp) *(u32x4*)((bf16_t*)(ws + WS_VS) + ((size_t)b * NKS + PAST + t) * 512 + 8 * lane) = vb;
        }
        if (lane < 8) { const float x = bf1(cu.fl) + a.in[26][lane]; const float lf = fminf(x, 0.f) - log1pf(__expf(-fabsf(x)));
            a.out[(samp ? O_LFS : O_LFP) + (size_t)ml * 8 + lane] = lf; }
        if (t == (samp ? TS - 1 : TP - 1)) { float* so = a.out + (samp ? O_SHS : O_SHP) + (size_t)b * RC;
            for (int c = lane; c < RC; c += 64) so[c] = bf1(pr[c]); }
    }
}

__device__ __forceinline__ void cumsum_block(LAS unsigned char* lds, const float* srcA, int nA, const float* srcB, int ntot, int tpt, float* dst  ) {
    const int tid = threadIdx.x, lane = tid & 63, wid = tid >> 6;
    LAS double* part = (LAS double*)lds;
    const int t0 = tid * tpt; const bool act = t0 < ntot;
    float s[8];
#pragma unroll
    for (int h = 0; h < 8; ++h) s[h] = 0.f;
    if (act) for (int i = 0; i < tpt; ++i) { const int t = t0 + i; const float* p = t < nA ? srcA + (size_t)t * 8 : srcB + (size_t)(t - nA) * 8; const f32x4 v0 = *(const f32x4*)p, v1 = *(const f32x4*)(p + 4);
        s[0] += v0[0]; s[1] += v0[1]; s[2] += v0[2]; s[3] += v0[3]; s[4] += v1[0]; s[5] += v1[1]; s[6] += v1[2]; s[7] += v1[3]; }
#pragma unroll
    for (int h = 0; h < 8; ++h) part[h * 512 + tid] = (double)s[h];
    __syncthreads();
    {
        double v[8]; double run = 0.0;
#pragma unroll
        for (int i = 0; i < 8; ++i) { v[i] = part[wid * 512 + lane * 8 + i]; run += v[i]; }
        double incl = run;
#pragma unroll
        for (int o = 1; o < 64; o <<= 1) { const double y = __shfl_up(incl, o); if (lane >= o) incl += y; }
        double ex = incl - run;
#pragma unroll
        for (int i = 0; i < 8; ++i) { const double tmp = v[i]; part[wid * 512 + lane * 8 + i] = ex; ex += tmp; }
    }
    __syncthreads();
    if (act) { double r[8];
#pragma unroll
        for (int h = 0; h < 8; ++h) r[h] = part[h * 512 + tid];
        for (int i = 0; i < tpt; ++i) { const int t = t0 + i; const float* p = t < nA ? srcA + (size_t)t * 8 : srcB + (size_t)(t - nA) * 8; const f32x4 v0 = *(const f32x4*)p, v1 = *(const f32x4*)(p + 4);
            r[0] += v0[0]; r[1] += v0[1]; r[2] += v0[2]; r[3] += v0[3]; r[4] += v1[0]; r[5] += v1[1]; r[6] += v1[2]; r[7] += v1[3];
#pragma unroll
            for (int h = 0; h < 8; ++h) dst[(size_t)h * ntot + t] = (float)(r[h] * (double)LOG2E); } }
    __syncthreads();
}

constexpr int CL = 64, NCH = TP / CL, SA_ITEMS = 32 * NCH + 64;
constexpr int SA_G = 0, SA_NKM = 16384, SA_AKN = 33024, SA_ABT = 49664, SA_NT = 66048, SA_RT = 75264, SA_BQ = 84480, SA_KQ = 93696, SA_BHK = 102912, SA_KH = 112128,
              SA_ABRT = 121344, SA_AKRT = 130560, SA_GL = 139776, SA_TOT = 140032, SA_Z = SA_BQ, SA_NP = SA_KQ, SA_OUT = 0;
__device__ __forceinline__ f32x4 mm_tile(const LAS unsigned char* X, const LAS unsigned char* Y, int tm, int tn, int lane) {
    f32x4 acc = {0.f, 0.f, 0.f, 0.f};
#pragma unroll
    for (int ks = 0; ks < 2; ++ks) {
        const bf16x8 xa = *(const LAS bf16x8*)(X + (16 * tm + (lane & 15)) * 144 + (32 * ks + 8 * (lane >> 4)) * 2);
        const bf16x8 yb = *(const LAS bf16x8*)(Y + (16 * tn + (lane & 15)) * 144 + (32 * ks + 8 * (lane >> 4)) * 2);
        acc = __builtin_amdgcn_mfma_f32_16x16x32_bf16(xa, yb, acc, 0, 0, 0);
    }
    return acc;
}
template <int u> __device__ __forceinline__ void sub_step(f32x2 (&xp)[32], const LAS float* A) {
    constexpr int G0 = (u + 1) / 4, NV = 16 - G0;
    f32x4 av[NV];
#pragma unroll
    for (int g = 0; g < NV; ++g) av[g] = *(const volatile LAS f32x4*)(A + u * 64 + 4 * (G0 + g));
#pragma unroll
    for (int g = 0; g < NV; ++g) {
        const f32x2 alo = {av[g][0], av[g][1]}, ahi = {av[g][2], av[g][3]};
        if constexpr ((u & 1) == 0)
            asm volatile("v_pk_fma_f32 %0, %2, %3, %0 op_sel_hi:[0,1,1]\n\tv_pk_fma_f32 %1, %2, %4, %1 op_sel_hi:[0,1,1]"
                         : "+v"(xp[2 * (G0 + g)]), "+v"(xp[2 * (G0 + g) + 1]) : "v"(xp[u >> 1]), "v"(alo), "v"(ahi));
        else
            asm volatile("v_pk_fma_f32 %0, %2, %3, %0 op_sel:[1,0,0] op_sel_hi:[1,1,1]\n\tv_pk_fma_f32 %1, %2, %4, %1 op_sel:[1,0,0] op_sel_hi:[1,1,1]"
                         : "+v"(xp[2 * (G0 + g)]), "+v"(xp[2 * (G0 + g) + 1]) : "v"(xp[u >> 1]), "v"(alo), "v"(ahi));
    }
    __builtin_amdgcn_sched_barrier(0);
}
template <int t0, int n> struct SubSteps { static __device__ __forceinline__ void run(f32x2 (&x)[32], const LAS float* A) { sub_step<t0>(x, A); SubSteps<t0 + 1, n - 1>::run(x, A); } };
template <int t0> struct SubSteps<t0, 0> { static __device__ __forceinline__ void run(f32x2 (&)[32], const LAS float*) {} };
struct SaRegs { u32x4 pr, pk, qr, qk, av; f32x4 w0, w1; };
__device__ __forceinline__ void sa_load(const Args& a, int item, SaRegs& R) {
    const int tid = threadIdx.x; unsigned char* ws = a.ws;
    const bf16_t* PR = (const bf16_t*)(ws + WS_PR); const float* WD = (const float*)(ws + WS_WDEC); const bf16_t* AG = (const bf16_t*)(ws + WS_AG);
    const bool samp = item >= 32 * NCH; const int bh = samp ? item - 32 * NCH : item >> 7, c = samp ? 0 : item & 127, b = bh >> 3, h = bh & 7;
    const int row0 = samp ? MP + b * TS : b * TP + c * CL; const int tl = tid >> 3, cgp = tid & 7, c0 = h * 64 + 8 * cgp, m = row0 + tl;
    const bf16_t* p = PR + (size_t)m * RC + c0; const bf16_t* q = PR + (size_t)(m > 0 ? m - 1 : 0) * RC + c0;
    R.pr = *(const u32x4*)p; R.pk = *(const u32x4*)(p + 512); R.qr = *(const u32x4*)q; R.qk = *(const u32x4*)(q + 512);
    R.av = *(const u32x4*)(AG + (size_t)m * 1024 + c0); const float* wp = WD + (size_t)m * 512 + c0; R.w0 = *(const f32x4*)wp; R.w1 = *(const f32x4*)(wp + 4);
}
__device__ __forceinline__ void sa_item(const Args& a, LAS unsigned char* lds, int item, const SaRegs& R, int prev_item) {
    const int tid = threadIdx.x, lane = tid & 63, wid = __builtin_amdgcn_readfirstlane(tid >> 6);
    unsigned char* ws = a.ws;
    const bf16_t* PR = (const bf16_t*)(ws + WS_PR); const float* WD = (const float*)(ws + WS_WDEC); const bf16_t* AG = (const bf16_t*)(ws + WS_AG); float* RK = (float*)(ws + WS_RK);
    const bool samp = item >= 32 * NCH; const int bh = samp ? item - 32 * NCH : item >> 7, c = samp ? 0 : item & 127, b = bh >> 3, h = bh & 7;
    const int row0 = samp ? MP + b * TS : b * TP + c * CL;
    const float* shift0 = samp ? a.in[6] + (size_t)b * RC : nullptr;
    LAS float* G = (LAS float*)(lds + SA_G); LAS float* GL = (LAS float*)(lds + SA_GL); LAS float* TOT = (LAS float*)(lds + SA_TOT);
    const int tl = tid >> 3, cgp = tid & 7, c0 = h * 64 + 8 * cgp, m = row0 + tl;
    float zr[8], nk[8], bb[8], kp[8];
    {
        float pr[8], pk[8], qr[8], qk[8], av[8];
        unpack8(R.pr, pr); unpack8(R.pk, pk); unpack8(R.qr, qr); unpack8(R.qk, qk); unpack8(R.av, av);
        const f32x4 w0 = R.w0, w1 = R.w1;
        if (c == 0 && tl == 0) {
#pragma unroll
            for (int j = 0; j < 8; ++j) { qr[j] = shift0 ? shift0[c0 + j] : 0.f; qk[j] = shift0 ? shift0[512 + c0 + j] : 0.f; }
        }
        const f32x4* m4 = (const f32x4*)(a.in[13] + c0); const f32x4 x0 = m4[0], x1 = m4[1], y0 = m4[128], y1 = m4[129];
        const f32x4* k4p = (const f32x4*)(a.in[19] + c0); const f32x4* a4p = (const f32x4*)(a.in[20] + c0); const f32x4* r4p = (const f32x4*)(a.in[21] + c0);
        const f32x4 kk0 = k4p[0], kk1 = k4p[1], ka0 = a4p[0], ka1 = a4p[1], rk0 = r4p[0], rk1 = r4p[1];
        float mur[8], muk[8], kkw[8], kaw[8], rkw[8];
#pragma unroll
        for (int j = 0; j < 4; ++j) { mur[j] = x0[j]; mur[4 + j] = x1[j]; muk[j] = y0[j]; muk[4 + j] = y1[j]; kkw[j] = kk0[j]; kkw[4 + j] = kk1[j]; kaw[j] = ka0[j]; kaw[4 + j] = ka1[j]; rkw[j] = rk0[j]; rkw[4 + j] = rk1[j]; }
        float zk[8], kk[8]; float ss = 0.f;
#pragma unroll
        for (int j = 0; j < 8; ++j) { zr[j] = pr[j] + (qr[j] - pr[j]) * mur[j]; zk[j] = pk[j] + (qk[j] - pk[j]) * muk[j]; kk[j] = zk[j] * kkw[j]; ss += kk[j] * kk[j]; }
        const float inv = 1.0f / fmaxf(sqrtf(sum8(ss)), 1e-12f); float rk = 0.f;
#pragma unroll
        for (int j = 0; j < 8; ++j) { const float kn = kk[j] * inv; nk[j] = -kn; bb[j] = kn * av[j]; kp[j] = zk[j] * (1.f + (av[j] - 1.f) * kaw[j]); rk += zr[j] * kp[j] * rkw[j]; }
        rk = sum8(rk);
        if (cgp == 0) RK[(size_t)m * 8 + h] = rk;
        *(LAS f32x4*)(G + tl * 64 + 8 * cgp) = w0; *(LAS f32x4*)(G + tl * 64 + 8 * cgp + 4) = w1;
    }
    __syncthreads();
    {
        const int k = tid & 63, part = tid >> 6; float run = 1.f; float g8[8];
#pragma unroll
        for (int i = 0; i < 8; ++i) g8[i] = G[(8 * part + i) * 64 + k];
#pragma unroll
        for (int i = 0; i < 8; ++i) { run *= g8[i]; g8[i] = run; }
        TOT[part * 64 + k] = run;
        __syncthreads();
        float tt[8];
#pragma unroll
        for (int p2 = 0; p2 < 8; ++p2) tt[p2] = TOT[p2 * 64 + k];
        float pre = 1.f;
#pragma unroll
        for (int p2 = 0; p2 < 8; ++p2) pre *= (p2 < part) ? tt[p2] : 1.f;
#pragma unroll
        for (int i = 0; i < 8; ++i) G[(8 * part + i) * 64 + k] = g8[i] * pre;
        if (part == 7) GL[k] = run * pre;
    }
    __syncthreads();
    {
        float nt[8], rt[8], bq[8], kq[8], bh8[8], kh8[8];
        const f32x4 gA = *(const LAS f32x4*)(G + tl * 64 + 8 * cgp), gB = *(const LAS f32x4*)(G + tl * 64 + 8 * cgp + 4), lA = *(const LAS f32x4*)(GL + 8 * cgp), lB = *(const LAS f32x4*)(GL + 8 * cgp + 4);
        const int tlp = tl > 0 ? tl - 1 : 0; const f32x4 pA = *(const LAS f32x4*)(G + tlp * 64 + 8 * cgp), pB = *(const LAS f32x4*)(G + tlp * 64 + 8 * cgp + 4);
#pragma unroll
        for (int j = 0; j < 8; ++j) { const float g = j < 4 ? gA[j & 3] : gB[j & 3], gp = tl > 0 ? (j < 4 ? pA[j & 3] : pB[j & 3]) : 1.f, gl = j < 4 ? lA[j & 3] : lB[j & 3], ig = __builtin_amdgcn_rcpf(g);
            nt[j] = gp * nk[j]; rt[j] = g * zr[j]; bq[j] = bb[j] * ig; kq[j] = kp[j] * ig; bh8[j] = bq[j] * gl; kh8[j] = kq[j] * gl; }
        *(LAS u32x4*)(lds + SA_NT + tl * 144 + cgp * 16) = pack8(nt); *(LAS u32x4*)(lds + SA_RT + tl * 144 + cgp * 16) = pack8(rt);
        *(LAS u32x4*)(lds + SA_BQ + tl * 144 + cgp * 16) = pack8(bq); *(LAS u32x4*)(lds + SA_KQ + tl * 144 + cgp * 16) = pack8(kq);
        *(LAS u32x4*)(lds + SA_KH + tl * 144 + cgp * 16) = pack8(kh8);
#pragma unroll
        for (int j = 0; j < 8; ++j) { const int k = 8 * cgp + j;
            ((LAS float*)(lds + SA_NKM))[k * 65 + tl] = nt[j]; ((LAS bf16_t*)(lds + SA_BHK))[k * 72 + tl] = (bf16_t)f2bf(bh8[j]); }
    }
    __syncthreads();
    {
        const int prod = wid >> 1, half = wid & 1;
        const LAS unsigned char* X = lds + ((prod & 1) ? SA_KQ : SA_BQ); const LAS unsigned char* Yb = lds + ((prod & 2) ? SA_RT : SA_NT);
        for (int ti = 0; ti < 8; ++ti) { const int tile = half * 8 + ti, tm = tile >> 2, tn = tile & 3;
            f32x4 acc = mm_tile(X, Yb, tm, tn, lane);
            const int s0 = 16 * tm + 4 * (lane >> 4), t = 16 * tn + (lane & 15);
#pragma unroll
            for (int r = 0; r < 4; ++r) { const int s = s0 + r; const bool keep = (prod & 2) ? (s <= t) : (s < t); if (!keep) acc[r] = 0.f; }
            if (prod == 0) { LAS float* o = (LAS float*)(lds + SA_ABT);
#pragma unroll
                for (int r = 0; r < 4; ++r) o[(s0 + r) * 64 + t] = acc[r]; }
            else if (prod == 1) { LAS float* o = (LAS float*)(lds + SA_AKN);
#pragma unroll
                for (int r = 0; r < 4; ++r) o[(s0 + r) * 65 + t] = acc[r]; }
            else { u32x2 w; w.x = pk2(acc[0], acc[1]); w.y = pk2(acc[2], acc[3]);
                *(LAS u32x2*)(lds + (prod == 2 ? SA_ABRT : SA_AKRT) + t * 144 + s0 * 2) = w; }
        }
    }
    if (prev_item >= 0) asm volatile("s_waitcnt vmcnt(0)" ::: "memory");
    __syncthreads();
    if (prev_item >= 0 && tid == 0) __hip_atomic_store((unsigned*)(ws + WS_CTL) + 1024 + prev_item, 1u, __ATOMIC_RELAXED, __HIP_MEMORY_SCOPE_AGENT);
    if (wid < 2) {
        const LAS float* rhs = (const LAS float*)(lds + (wid == 0 ? SA_AKN : SA_NKM)) + lane * 65; const LAS float* At = (const LAS float*)(lds + SA_ABT);
        f32x2 xp[32];
#pragma unroll
        for (int t = 0; t < 32; ++t) xp[t] = (f32x2){rhs[2 * t], rhs[2 * t + 1]};
        SubSteps<0, 63>::run(xp, At);
        LAS unsigned char* o = lds + (wid == 0 ? SA_Z : SA_NP) + lane * 144;
#pragma unroll
        for (int g8 = 0; g8 < 8; ++g8) { u32x4 w; w.x = pk2(xp[4 * g8][0], xp[4 * g8][1]); w.y = pk2(xp[4 * g8 + 1][0], xp[4 * g8 + 1][1]); w.z = pk2(xp[4 * g8 + 2][0], xp[4 * g8 + 2][1]); w.w = pk2(xp[4 * g8 + 3][0], xp[4 * g8 + 3][1]); *(LAS u32x4*)(o + g8 * 16) = w; }
    }
    __syncthreads();
    {
        const int prod = wid >> 1, half = wid & 1;
        const LAS unsigned char* X = lds + ((prod == 0 || prod == 3) ? SA_BHK : SA_ABRT); const LAS unsigned char* Yb = lds + ((prod < 2) ? SA_NP : SA_Z);
        LAS bf16_t* OUT = (LAS bf16_t*)(lds + SA_OUT);
        const int rbase = (prod == 0 || prod == 3) ? 64 : 0, cbase = (prod < 2) ? 0 : 64;
        for (int ti = 0; ti < 8; ++ti) { const int tile = half * 8 + ti, tm = tile >> 2, tn = tile & 3;
            f32x4 acc = mm_tile(X, Yb, tm, tn, lane);
            const int m0 = 16 * tm + 4 * (lane >> 4), n = 16 * tn + (lane & 15);
            const LAS bf16_t* ap = (const LAS bf16_t*)(lds + (prod == 1 ? SA_RT : prod == 2 ? SA_AKRT : SA_KH)) + (prod == 3 ? n * 72 + m0 : m0 * 72 + n);
            const int st = (prod == 3) ? 1 : 72;
            const bf16_t a0 = ap[0], a1 = ap[st], a2 = ap[2 * st], a3 = ap[3 * st]; const float gl = GL[n];
            float addv[4] = {bf1(a0), bf1(a1), bf1(a2), bf1(a3)};
            if (prod == 0) {
#pragma unroll
                for (int r = 0; r < 4; ++r) addv[r] = (m0 + r == n) ? gl : 0.f; }
#pragma unroll
            for (int r = 0; r < 4; ++r) OUT[(rbase + m0 + r) * 136 + cbase + n] = (bf16_t)f2bf(acc[r] + addv[r]); }
    }
    __syncthreads();
    {
        unsigned char* dst = (unsigned char*)(a.out + O_Y) + (size_t)item * 32768;
#pragma unroll
        for (int ps = 0; ps < 4; ++ps) { const int idx = ps * 512 + tid, row = idx >> 4, ch = idx & 15;
            const u32x4 v = *(const LAS u32x4*)(lds + SA_OUT + row * 272 + ch * 16); unsigned char* gp = dst + row * 256 + ch * 16;
            asm volatile("global_store_dwordx4 %0, %1, off sc1\n\ts_nop 1" :: "v"(gp), "v"(v) : "memory"); }
    }
    __syncthreads();
}

constexpr int SB_A = 0, SB_B0 = 17408, SB_B1 = 17408 + 34816;
__device__ __forceinline__ void sb_chain(const Args& a, LAS unsigned char* lds, int item0, int nch, int row0, int h, const float* S0, float* Sout, const float* shift0) {
    const int tid = threadIdx.x, lane = tid & 63, wid = __builtin_amdgcn_readfirstlane(tid >> 6);
    unsigned char* ws = a.ws;
    const bf16_t* PR = (const bf16_t*)(ws + WS_PR); float* Y = (float*)(ws + WS_Y);
    LAS bf16_t* AI = (LAS bf16_t*)(lds + SB_A);
    const int tl = tid >> 3, cgp = tid & 7, c0 = 1024 + h * 64 + 8 * cgp;
    const f32x4 mv0 = *(const f32x4*)(a.in[13] + c0), mv1 = *(const f32x4*)(a.in[13] + c0 + 4);
    struct ChunkRegs { u32x4 b[4], pv, qv; };
    ChunkRegs r0, r1, r2, r3;
    auto load_chunk = [&](int c, ChunkRegs& R) {
        const unsigned char* src = (const unsigned char*)(a.out + O_Y) + (size_t)(item0 + c) * 32768;
#pragma unroll
        for (int ps = 0; ps < 4; ++ps) R.b[ps] = *(const u32x4*)(src + (ps * 512 + tid) * 16);
        const int m = row0 + c * CL + tl; R.pv = *(const u32x4*)(PR + (size_t)m * RC + c0); R.qv = *(const u32x4*)(PR + (size_t)(m > 0 ? m - 1 : 0) * RC + c0); };
    auto store_chunk = [&](int c, const ChunkRegs& R) {
        LAS unsigned char* B = lds + ((c & 1) ? SB_B1 : SB_B0);
#pragma unroll
        for (int ps = 0; ps < 4; ++ps) { const int idx = ps * 512 + tid, row = idx >> 4, ch = idx & 15; *(LAS u32x4*)(B + row * 272 + ch * 16) = R.b[ps]; }
        float pv[8], qv[8]; unpack8(R.pv, pv); unpack8(R.qv, qv);
        if (c == 0 && tl == 0) {
#pragma unroll
            for (int j = 0; j < 8; ++j) qv[j] = shift0 ? shift0[c0 + j] : 0.f; }
        const float mu[8] = {mv0[0], mv0[1], mv0[2], mv0[3], mv1[0], mv1[1], mv1[2], mv1[3]};
#pragma unroll
        for (int j = 0; j < 8; ++j) AI[(8 * cgp + j) * 136 + 64 + tl] = (bf16_t)f2bf(pv[j] + (qv[j] - pv[j]) * mu[j]); };
    for (int e = tid; e < 4096; e += 512) AI[(e >> 6) * 136 + (e & 63)] = S0 ? (bf16_t)f2bf(S0[e]) : (bf16_t)0;
    unsigned* flags = (unsigned*)(ws + WS_CTL) + 1024 + item0;
    int ready = 0;
#define SB_WAIT_BATCH() do { const int hi_ = (ready + 16 < nch) ? ready + 16 : nch; \
        if (tid == 0) { for (;;) { unsigned v_ = 1u; for (int k_ = ready; k_ < hi_; ++k_) { const unsigned f_ = __hip_atomic_load(flags + k_, __ATOMIC_RELAXED, __HIP_MEMORY_SCOPE_AGENT); v_ = f_ < v_ ? f_ : v_; } \
                if (v_ != 0u) break; __builtin_amdgcn_s_sleep(8); } \
            __builtin_amdgcn_fence(__ATOMIC_ACQUIRE, "agent"); asm volatile("s_waitcnt vmcnt(0)" ::: "memory"); } \
        ready = hi_; } while (0)
    SB_WAIT_BATCH();
    __syncthreads();
    load_chunk(0, r0); store_chunk(0, r0);
    if (nch > 1) load_chunk(1, r1);
    if (nch > 2) load_chunk(2, r2);
    if (nch > 3) load_chunk(3, r3);
    if (nch > 4) load_chunk(4, r0);
    __syncthreads();
    const int tm = wid & 3, tn0 = 4 * (wid >> 2);
    f32x4 acc[4];
#define SB_STEP(c, RN) do { \
        const LAS unsigned char* B = lds + (((c) & 1) ? SB_B1 : SB_B0); \
        _Pragma("unroll") for (int q = 0; q < 4; ++q) acc[q] = (f32x4){0.f, 0.f, 0.f, 0.f}; \
        _Pragma("unroll") for (int ks = 0; ks < 4; ++ks) { \
            const bf16x8 xa = *(const LAS bf16x8*)(lds + SB_A + (16 * tm + (lane & 15)) * 272 + (32 * ks + 8 * (lane >> 4)) * 2); \
            _Pragma("unroll") for (int q = 0; q < 4; ++q) { const bf16x8 yb = *(const LAS bf16x8*)(B + (16 * (tn0 + q) + (lane & 15)) * 272 + (32 * ks + 8 * (lane >> 4)) * 2); \
                acc[q] = __builtin_amdgcn_mfma_f32_16x16x32_bf16(xa, yb, acc[q], 0, 0, 0); } } \
        const int i0 = 16 * tm + 4 * (lane >> 4); \
        if (wid < 4) { _Pragma("unroll") for (int q = 0; q < 4; ++q) { const int t = 16 * q + (lane & 15); *(f32x4*)(Y + (size_t)(row0 + (c) * CL + t) * 512 + h * 64 + i0) = acc[q]; } } \
        __syncthreads(); \
        if (wid >= 4) { \
            _Pragma("unroll") for (int q = 0; q < 4; ++q) { const int kq = 16 * q + (lane & 15); _Pragma("unroll") for (int r = 0; r < 4; ++r) AI[(i0 + r) * 136 + kq] = (bf16_t)f2bf(acc[q][r]); } \
            if ((c) == nch - 1) { _Pragma("unroll") for (int q = 0; q < 4; ++q) { const int kq = 16 * q + (lane & 15); _Pragma("unroll") for (int r = 0; r < 4; ++r) Sout[(size_t)(i0 + r) * 64 + kq] = acc[q][r]; } } } \
        if ((c) + 1 < nch) store_chunk((c) + 1, RN); \
        if ((c) + 5 < nch && (c) + 5 >= ready) SB_WAIT_BATCH(); \
        __syncthreads(); \
        if ((c) + 5 < nch) load_chunk((c) + 5, RN); } while (0)
    for (int c = 0; c < nch; c += 4) {
        SB_STEP(c, r1);
        if (c + 1 < nch) SB_STEP(c + 1, r2);
        if (c + 2 < nch) SB_STEP(c + 2, r3);
        if (c + 3 < nch) SB_STEP(c + 3, r0);
    }
#undef SB_STEP
#undef SB_WAIT_BATCH
}

constexpr int AT_K0 = 0, AT_K1 = 9216, AT_V0 = 18432, AT_V1 = 30720, AT_NB0 = 43008, AT_NB1 = 43264, AT_WSF = 43520, AT_CNT = 45568;
__device__ __forceinline__ void attn_unit(LAS unsigned char* lds, const bf16_t* Q, int ldq, const bf16_t* K, const bf16_t* V, int ldkv, const float* lc2,
                                          bf16_t* O, int ldo, int nq_valid, int qpos0, float U2x2, float T2) {
    const int tid = threadIdx.x, lane = tid & 63, r32 = lane & 31, hi = lane >> 5, wid = __builtin_amdgcn_readfirstlane(tid >> 6);
    const int jmax = (qpos0 + nq_valid - 1) >> 6, ntile = jmax + 1;
    LAS float* wsf = (LAS float*)(lds + AT_WSF) + wid * 64; LAS int* cnt = (LAS int*)(lds + AT_CNT);
    const float Lq0 = lc2[qpos0];
    bool drop = false;
    if (tid < ntile) { const int kend = 64 * tid + 63; if (kend <= qpos0) drop = (Lq0 - lc2[kend] + U2x2 < -T2); }
    { const unsigned long long bal = __ballot(drop); if (lane == 0) cnt[wid] = __popcll(bal); }
    __syncthreads();
    int tlo = 0;
#pragma unroll
    for (int w = 0; w < 8; ++w) tlo += cnt[w];
    const float Lref = lc2[64 * tlo];
    const bool active = 32 * wid < nq_valid;
    const int qp_lo = qpos0 + 32 * wid, qp_hi = qp_lo + 31, qpos = qp_lo + r32;
    const float Lqw = active ? lc2[qp_lo] - Lref : 0.f;
    bf16x8 qr[4];
    if (active) {
#pragma unroll
        for (int d0 = 0; d0 < 4; ++d0) qr[d0] = *(const bf16x8*)(Q + (size_t)(32 * wid + r32) * ldq + d0 * 16 + hi * 8);
    } else {
#pragma unroll
        for (int d0 = 0; d0 < 4; ++d0) qr[d0] = (bf16x8){0, 0, 0, 0, 0, 0, 0, 0};
    }
    float m_run = -1e30f, l_run = 0.f; f32x16 o0 = {}, o1 = {};
    const int srow = tid >> 3, sch = tid & 7;
    u32x4 kreg, vreg; float nbreg = 0.f;
    auto load_tile = [&](int j) {
        kreg = *(const u32x4*)(K + (size_t)(64 * j + srow) * ldkv + 8 * sch); vreg = *(const u32x4*)(V + (size_t)(64 * j + srow) * ldkv + 8 * sch);
        if (tid < 64) nbreg = Lref - lc2[64 * j + tid]; };
    auto store_tile = [&](int b) {
        *(LAS u32x4*)(lds + (b ? AT_K1 : AT_K0) + srow * 144 + sch * 16) = kreg; *(LAS u32x4*)(lds + (b ? AT_V1 : AT_V0) + srow * 192 + sch * 16) = vreg;
        if (tid < 64) ((LAS float*)(lds + (b ? AT_NB1 : AT_NB0)))[tid] = nbreg; };
    load_tile(jmax); store_tile(0);
    __syncthreads();
    int buf = 0;
    for (int j = jmax; j >= tlo; --j) {
        if (j > tlo) load_tile(j - 1);
        const LAS unsigned char* Kt = lds + (buf ? AT_K1 : AT_K0); const LAS unsigned char* Vt = lds + (buf ? AT_V1 : AT_V0); const LAS float* NB = (const LAS float*)(lds + (buf ? AT_NB1 : AT_NB0));
        bool need = active && (64 * j <= qp_hi);
        if (need && (64 * j + 63 < qp_lo)) need = (Lqw + NB[63] + U2x2 >= -T2);
        if (need) {
            f32x16 p0 = {}, p1 = {};
#pragma unroll
            for (int d0 = 0; d0 < 4; ++d0) { const bf16x8 a0 = *(const LAS bf16x8*)(Kt + r32 * 144 + d0 * 32 + hi * 16), a1 = *(const LAS bf16x8*)(Kt + (32 + r32) * 144 + d0 * 32 + hi * 16);
                p0 = __builtin_amdgcn_mfma_f32_32x32x16_bf16(a0, qr[d0], p0, 0, 0, 0); p1 = __builtin_amdgcn_mfma_f32_32x32x16_bf16(a1, qr[d0], p1, 0, 0, 0); }
#pragma unroll
            for (int aa = 0; aa < 4; ++aa) { const f32x4 n0 = *(const LAS f32x4*)(NB + 8 * aa + 4 * hi), n1 = *(const LAS f32x4*)(NB + 32 + 8 * aa + 4 * hi);
#pragma unroll
                for (int b = 0; b < 4; ++b) { p0[4 * aa + b] += n0[b]; p1[4 * aa + b] += n1[b]; } }
            if (64 * j + 63 > qp_lo) {
#pragma unroll
                for (int r = 0; r < 16; ++r) { const int key = 64 * j + (r & 3) + 8 * (r >> 2) + 4 * hi; if (key > qpos) p0[r] = -1e30f; if (key + 32 > qpos) p1[r] = -1e30f; }
            }
            float rm = fmaxf(p0[0], p1[0]);
#pragma unroll
            for (int r = 1; r < 16; ++r) rm = fmaxf(rm, fmaxf(p0[r], p1[r]));
            rm = fmaxf(rm, __shfl_xor(rm, 32));
            if (__any(rm > m_run)) {
                const float mn = fmaxf(m_run, rm), f = __builtin_amdgcn_exp2f(m_run - mn); l_run *= f; m_run = mn;
                if (hi == 0) wsf[r32] = f;
                asm volatile("s_waitcnt lgkmcnt(0)" ::: "memory");
#pragma unroll
                for (int aa = 0; aa < 4; ++aa) { const f32x4 f4 = *(const LAS f32x4*)(wsf + 8 * aa + 4 * hi);
#pragma unroll
                    for (int b = 0; b < 4; ++b) { o0[4 * aa + b] *= f4[b]; o1[4 * aa + b] *= f4[b]; } }
            }
            float ls = 0.f;
#pragma unroll
            for (int r = 0; r < 16; ++r) { p0[r] = __builtin_amdgcn_exp2f(p0[r] - m_run); p1[r] = __builtin_amdgcn_exp2f(p1[r] - m_run); ls += p0[r] + p1[r]; }
            l_run += ls;
            bf16x8 pa[4];
#pragma unroll
            for (int s = 0; s < 4; ++s) { u32x4 w;
                if (s < 2) { w.x = pk2(p0[8 * s + 0], p0[8 * s + 1]); w.y = pk2(p0[8 * s + 2], p0[8 * s + 3]); w.z = pk2(p0[8 * s + 4], p0[8 * s + 5]); w.w = pk2(p0[8 * s + 6], p0[8 * s + 7]); }
                else { const int s2 = s - 2; w.x = pk2(p1[8 * s2 + 0], p1[8 * s2 + 1]); w.y = pk2(p1[8 * s2 + 2], p1[8 * s2 + 3]); w.z = pk2(p1[8 * s2 + 4], p1[8 * s2 + 5]); w.w = pk2(p1[8 * s2 + 6], p1[8 * s2 + 7]); }
                pa[s] = __builtin_bit_cast(bf16x8, w); }
            const LAS unsigned char* vb = Vt + (4 * hi + ((lane & 15) >> 2)) * 192 + (16 * ((lane >> 4) & 1) + 4 * (lane & 3)) * 2;
#pragma unroll
            for (int s = 0; s < 4; ++s) { const int kvb = (s & 1) * 16 + (s >> 1) * 32;
#pragma unroll
                for (int dh = 0; dh < 2; ++dh) { const LAS unsigned char* p = vb + kvb * 192 + dh * 64;
                    const v4i16_t lo = __builtin_amdgcn_ds_read_tr16_b64_v4i16((LAS v4i16_t*)p), hi4 = __builtin_amdgcn_ds_read_tr16_b64_v4i16((LAS v4i16_t*)(p + 8 * 192));
                    const bf16x8 bv = (bf16x8){lo[0], lo[1], lo[2], lo[3], hi4[0], hi4[1], hi4[2], hi4[3]};
                    if (dh == 0) o0 = __builtin_amdgcn_mfma_f32_32x32x16_bf16(pa[s], bv, o0, 0, 0, 0); else o1 = __builtin_amdgcn_mfma_f32_32x32x16_bf16(pa[s], bv, o1, 0, 0, 0); } }
        }
        if (j > tlo) store_tile(buf ^ 1);
        __syncthreads();
        buf ^= 1;
    }
    if (active) {
        const float lt = l_run + __shfl_xor(l_run, 32);
        if (hi == 0) wsf[32 + r32] = 1.0f / lt;
        asm volatile("s_waitcnt lgkmcnt(0)" ::: "memory");
#pragma unroll
        for (int aa = 0; aa < 4; ++aa) { const f32x4 i4 = *(const LAS f32x4*)(wsf + 32 + 8 * aa + 4 * hi);
#pragma unroll
            for (int b = 0; b < 4; ++b) { const int q = 32 * wid + 8 * aa + 4 * hi + b; bf16_t* op = O + (size_t)q * ldo + r32;
                op[0] = (bf16_t)f2bf(o0[4 * aa + b] * i4[b]); op[32] = (bf16_t)f2bf(o1[4 * aa + b] * i4[b]); } }
    }
    __syncthreads();
}

__device__ __forceinline__ void phase5(const Args& a, LAS unsigned char* lds) {
    const int tid = threadIdx.x, lane = tid & 63;
    unsigned char* ws = a.ws;
    float gq = fabsf(a.in[24][lane]), gk = fabsf(a.in[25][lane]);
#pragma unroll
    for (int o = 1; o < 64; o <<= 1) { gq = fmaxf(gq, __shfl_xor(gq, o)); gk = fmaxf(gk, __shfl_xor(gk, o)); }
    const float U2x2 = 2.0f * 8.0f * gq * gk * LOG2E * 1.03f + 0.5f, T2 = 20.0f * LOG2E;
    unsigned* ctr = (unsigned*)(ws + WS_CTL) + 64; LAS unsigned* su = (LAS unsigned*)(lds + AT_CNT + 64);
    bf16_t* PF = (bf16_t*)(ws + WS_PF);
    for (;;) {
        if (tid == 0) *su = atomicAdd(ctr, 1u);
        __syncthreads();
        const unsigned u = *su;
        __syncthreads();
        if (u >= 1024u + 64u) break;
        if (u < 1024u) { const int bh = u >> 5, qb = u & 31, b = bh >> 3, h = bh & 7; bf16_t* base = PF + (size_t)(b * TP) * RC + h * 64;
            attn_unit(lds, base + (size_t)(256 * qb) * RC, RC, base + 512, base + 1024, RC, (const float*)(ws + WS_LCP) + (size_t)bh * TP, base + (size_t)(256 * qb) * RC, RC, 256, 256 * qb, U2x2, T2); }
        else { const int bh = u - 1024, b = bh >> 3, h = bh & 7; bf16_t* qb_ = PF + (size_t)(MP + b * TS) * RC + h * 64;
            attn_unit(lds, qb_, RC, (const bf16_t*)(ws + WS_KS) + (size_t)b * NKS * 512 + h * 64, (const bf16_t*)(ws + WS_VS) + (size_t)b * NKS * 512 + h * 64, 512,
                      (const float*)(ws + WS_LCS) + (size_t)bh * NKS, qb_, RC, TS, PAST, U2x2, T2); }
    }
}

__device__ __forceinline__ void phase6(const Args& a, const pg8::RowSet rs, int rank, int pool, int opq) {
    const int tidq = threadIdx.x + opq; const int lane = tidq & 63, gw = rank * 8 + (tidq >> 6), NGW = pool * 8;
    unsigned char* ws = a.ws;
    const bf16_t* PR = (const bf16_t*)(ws + WS_PR); bf16_t* PF = (bf16_t*)(ws + WS_PF); const bf16_t* AG = (const bf16_t*)(ws + WS_AG);
    const float* Y = (const float*)(ws + WS_Y); const float* RK = (const float*)(ws + WS_RK);
    const int c = 8 * lane, nr = rs.nrows();
    struct P6Regs { f32x4 y0, y1; u32x4 pv, qv, g; float rk; };
    P6Regs nx;
    auto ldrow = [&](int r) { const int m = rs.grow(r);
        nx.y0 = *(const f32x4*)(Y + (size_t)m * 512 + c); nx.y1 = *(const f32x4*)(Y + (size_t)m * 512 + c + 4);
        nx.pv = *(const u32x4*)(PR + (size_t)m * RC + 1024 + c); nx.qv = *(const u32x4*)(PR + (size_t)(m > 0 ? m - 1 : 0) * RC + 1024 + c);
        nx.g = *(const u32x4*)(AG + (size_t)m * 1024 + 512 + c); nx.rk = RK[(size_t)m * 8 + (lane >> 3)]; };
    if (gw < nr) ldrow(gw);
    for (int r = gw; r < nr; r += NGW) {
        const int m = rs.grow(r);
        const bool samp = m >= MP; const int ml = samp ? m - MP : m; const int b = samp ? (ml >> 6) : (ml >> 13); const int t = samp ? (ml & 63) : (ml & 8191);
        const P6Regs cu = nx;
        if (r + NGW < nr) ldrow(r + NGW);
        const f32x4 y0 = cu.y0, y1 = cu.y1;
        float y[8] = {y0[0], y0[1], y0[2], y0[3], y1[0], y1[1], y1[2], y1[3]}; float s = 0.f;
#pragma unroll
        for (int j = 0; j < 8; ++j) s += y[j];
        const float mean = sum8(s) * (1.f / 64.f); float q = 0.f;
#pragma unroll
        for (int j = 0; j < 8; ++j) { y[j] -= mean; q += y[j] * y[j]; }
        const float rstd = rsqrtf(sum8(q) * (1.f / 64.f) + 64e-5f);
        float pv[8], qv[8], g[8]; unpack8(cu.pv, pv);
        if (t > 0) unpack8(cu.qv, qv);
        else {
#pragma unroll
            for (int j = 0; j < 8; ++j) qv[j] = samp ? a.in[6][(size_t)b * RC + 1024 + c + j] : 0.f; }
        unpack8(cu.g, g);
        const float rk = cu.rk; float o[8];
#pragma unroll
        for (int j = 0; j < 8; ++j) { const float zv = pv[j] + (qv[j] - pv[j]) * a.in[13][1024 + c + j]; o[j] = (y[j] * rstd * a.in[22][c + j] + a.in[23][c + j] + rk * zv) * g[j]; }
        *(u32x4*)(PF + (size_t)m * RC + 512 + c) = pack8(o);
    }
}
__device__ __forceinline__ void norm2_rows(const Args& a, const pg8::RowSet rs, int rank, int pool, const float* X1b, bf16_t* H2b, const float* mod, int opq) {
    const int tidq = threadIdx.x + opq; const int lane = tidq & 63, gw = rank * 8 + (tidq >> 6), NGW = pool * 8, nr = rs.nrows();
    const float* gvec = a.in[28];
    f32x4 nx[4];
    auto ldrow = [&](int r) { const float* xr = X1b + (size_t)rs.grow(r) * DM;
#pragma unroll
        for (int j = 0; j < 4; ++j) nx[j] = *(const f32x4*)(xr + 4 * lane + 256 * j); };
    if (gw < nr) ldrow(gw);
    for (int r = gw; r < nr; r += NGW) {
        const int m = rs.grow(r); const size_t br = (size_t)rs.brow(r);
        const float* mr = mod + (size_t)batch_of_row(m) * 6144;
        f32x4 v[4]; float s = 0.f;
#pragma unroll
        for (int j = 0; j < 4; ++j) { v[j] = nx[j]; s += (v[j][0] * v[j][0] + v[j][1] * v[j][1]) + (v[j][2] * v[j][2] + v[j][3] * v[j][3]); }
        if (r + NGW < nr) ldrow(r + NGW);
        const float rinv = rsqrtf(wave_sum(s) * (1.f / DM) + 1e-6f);
#pragma unroll
        for (int j = 0; j < 4; ++j) { const int c = 4 * lane + 256 * j; const f32x4 g = *(const f32x4*)(gvec + c), sc = *(const f32x4*)(mr + 4096 + c), sh = *(const f32x4*)(mr + 3072 + c);
            f32x4 o;
#pragma unroll
            for (int q = 0; q < 4; ++q) o[q] = v[j][q] * rinv * g[q] * (1.f + sc[q]) + sh[q];
            u32x2 w; w.x = pk2(o[0], o[1]); w.y = pk2(o[2], o[3]); *(u32x2*)(H2b + br * DM + c) = w; }
    }
}

constexpr int NPHASE = 6;

__global__ void __launch_bounds__(512, 2) mk_fwd(Args a) {
    extern __shared__ __attribute__((aligned(16))) unsigned char lds_raw[];
    LAS unsigned char* lds = (LAS unsigned char*)lds_raw;
    cg::grid_group grid = cg::this_grid();
#define GRID_BAR() do { XcdBarrier xb_; xb_.bar = (unsigned*)(a.ws + WS_CTL) + 6000; xb_.x = xb_xcc_id(); xb_.st = (volatile LAS unsigned*)(lds + 147200); xcd_barrier(xb_, false); } while (0)
#define GRID_BAR_FIRST() do { XcdBarrier xb_; xb_.bar = (unsigned*)(a.ws + WS_CTL) + 6000; xb_.x = xb_xcc_id(); xb_.st = (volatile LAS unsigned*)(lds + 147200); xcd_barrier(xb_, true); } while (0)
    unsigned char* ws = a.ws;
    const int lo = a.ph_lo, hi = a.ph_hi, G = gridDim.x, blk = blockIdx.x;
#define IN(k) (lo <= (k) && (k) < hi)
#define SEAM(k) do { if (IN(k) && IN((k) + 1)) { if (lo < 0) grid.sync(); else if ((k) == lo) GRID_BAR_FIRST(); else GRID_BAR(); } } while (0)
    float* mod = (float*)(ws + WS_MOD);
    if (IN(0)) { for (int rep = 0; rep < REP_ROWS; ++rep) phase0(a, lds); } SEAM(0);
    if (IN(1)) { for (int rep = 0; rep < REP_ROWS; ++rep) norm_rows(a.in[0], a.in[1], a.in[9], mod, 0, 1024, (bf16_t*)(ws + WS_XN)); } SEAM(1);
    if (IN(2)) { pg8::Gemm g{(const bf16_t*)(ws + WS_XN), (const bf16_t*)(ws + WS_WIN), MT, NPAD, 1024, 1024}; pg8::StaticOrder S; S.init(MT, NPAD, G, blk);
        pg8::EpiProj E{(bf16_t*)(ws + WS_PR), (bf16_t*)(ws + WS_PF)}; pg8::gemm_phase<pg8::EpiProj, pg8::StaticOrder, true>(lds, g, S, E); } SEAM(2);
    if (IN(3)) { phase3(a); } SEAM(3);
    if (IN(4)) {
        {
            const int it = (G >= 12) ? blk - (G - 12) : -1;
            if (it >= 0) {
                const bool pr = it < 4; const int b = pr ? it : it - 4;
                const float* sA = pr ? a.out + O_LFP + (size_t)b * TP * 8 : a.in[4] + (size_t)b * PAST * 8;
                const float* sB = a.out + O_LFS + (size_t)b * TS * 8;
                float* dst = pr ? (float*)(ws + WS_LCP) + (size_t)b * 8 * TP : (float*)(ws + WS_LCS) + (size_t)b * 8 * NKS;
                cumsum_block(lds, sA, pr ? TP : PAST, sB, pr ? TP : NKS, pr ? 16 : 8, dst);
            }
        }
        pg8::Gemm g{(const bf16_t*)(ws + WS_A2), (const bf16_t*)(ws + WS_WL), MT, 1536, 256, 256}; pg8::StaticOrder S; S.init(MT, 1536, G, blk);
        pg8::EpiLora E{(float*)(ws + WS_WDEC), (bf16_t*)(ws + WS_AG), a.in[14], a.in[16]}; pg8::gemm_phase<pg8::EpiLora, pg8::StaticOrder, true>(lds, g, S, E); } SEAM(4);
    if (IN(5)) {
        unsigned* ctl = (unsigned*)(ws + WS_CTL);
        if (blk < 32) {
            const int bh = blk, b = bh >> 3;
            sb_chain(a, lds, bh * NCH, NCH, b * TP, bh & 7, nullptr, a.out + O_STP + (size_t)bh * 4096, nullptr);
        } else {
            const int NSA = G - 32;
#define SA_ITEM_OF(q) ((q) < 64 ? 32 * NCH + (q) : (((q) - 64) & 31) * NCH + (((q) - 64) >> 5))
            int prev = -1; SaRegs cur, nxt; if (blk - 32 < SA_ITEMS) sa_load(a, SA_ITEM_OF(blk - 32), cur);
            for (int q = blk - 32; q < SA_ITEMS; q += NSA) { if (q + NSA < SA_ITEMS) sa_load(a, SA_ITEM_OF(q + NSA), nxt); sa_item(a, lds, SA_ITEM_OF(q), cur, prev); prev = SA_ITEM_OF(q); cur = nxt; }
            if (prev >= 0) { asm volatile("s_waitcnt vmcnt(0)" ::: "memory"); __syncthreads();
                if (threadIdx.x == 0) __hip_atomic_store(ctl + 1024 + prev, 1u, __ATOMIC_RELAXED, __HIP_MEMORY_SCOPE_AGENT); }
#undef SA_ITEM_OF
            if (blk < 96) { const int bh = blk - 32, b = bh >> 3;
                sb_chain(a, lds, 32 * NCH + bh, 1, MP + b * TS, bh & 7, a.in[5] + (size_t)bh * 4096, a.out + O_STS + (size_t)bh * 4096, a.in[6] + (size_t)b * RC); }
        }
        phase5(a, lds);
        GRID_BAR();
        {
            const pg8::RowSet rs{1, 0}; const int pool = G, rank = blk; unsigned* bw = ctl + 808;
            float* X1b = a.out + O_Y; bf16_t* H2b = (bf16_t*)(ws + WS_XN); bf16_t* ACTb = (bf16_t*)(ws + WS_ACT);
            phase6(a, rs, rank, pool, 0);
            GRID_BAR();
            { pg8::Gemm g{(const bf16_t*)(ws + WS_PF), (const bf16_t*)(ws + WS_WO), MT, 1024, 1024, RC}; pg8::MapOrder S{rs, 4, pool, rank, 1};
              pg8::EpiResid E{a.in[0], a.in[1], nullptr, X1b, nullptr, mod + 2048}; pg8::gemm_phase<pg8::EpiResid, pg8::MapOrder, true>(lds, g, S, E); }
            GRID_BAR();
            norm2_rows(a, rs, rank, pool, X1b, H2b, mod, 0);
            GRID_BAR();
            { pg8::Gemm g{H2b, (const bf16_t*)(ws + WS_WGU), MT, 2 * DFF, 1024, 1024}; pg8::MapOrder S{rs, 22, pool, rank, 0};
              pg8::EpiSwiglu E{ACTb}; pg8::gemm_phase<pg8::EpiSwiglu, pg8::MapOrder, true>(lds, g, S, E); }
            GRID_BAR();
            { pg8::Gemm g{ACTb, (const bf16_t*)(ws + WS_WD), MT, 1024, DFF, DFF}; pg8::MapOrder S{rs, 4, pool, rank, 0};
              pg8::EpiResid E{X1b, X1b + (size_t)MP * DM, nullptr, X1b, nullptr, mod + 5120}; pg8::gemm_phase<pg8::EpiResid, pg8::MapOrder, true>(lds, g, S, E); }
        }
    }
#undef IN
#undef SEAM
}

#ifndef MK_N_LAUNCHES
#define MK_N_LAUNCHES 1
#endif
extern "C" void kernel_launch(void* const* d_in, const int* in_sizes, int n_in, void* d_out, int out_size, void* d_ws, size_t ws_size, hipStream_t stream) {
    static int grid = 0;
    if (grid == 0) {
        if (n_in != 32 || ws_size < WS_END) { fprintf(stderr, "kernel_launch: unexpected n_in %d / ws %zu\n", n_in, ws_size); grid = -1; return; }
        int dev = 0, cus = 0, per_cu = 0;
        hipGetDevice(&dev); hipDeviceGetAttribute(&cus, hipDeviceAttributeMultiprocessorCount, dev);
        hipFuncSetAttribute((const void*)mk_fwd, hipFuncAttributeMaxDynamicSharedMemorySize, LDS_BYTES);
        hipOccupancyMaxActiveBlocksPerMultiprocessor(&per_cu, (const void*)mk_fwd, 512, LDS_BYTES);
        (void)hipGetLastError();
        if (per_cu < 1) per_cu = 1;
        grid = cus;
        if (grid < 1) grid = 256;
    }
    if (grid < 0) return;
    hipMemsetAsync((char*)d_ws + WS_CTL, 0, 40960, stream);
    Args a{};
    for (int i = 0; i < 32; ++i) a.in[i] = (const float*)d_in[i];
    a.out = (float*)d_out; a.ws = (unsigned char*)d_ws;
    if (MK_N_LAUNCHES == 1) {
        a.ph_lo = 0; a.ph_hi = NPHASE; void* args[] = {&a};
        hipError_t e = hipLaunchCooperativeKernel((const void*)mk_fwd, dim3(grid), dim3(512), args, LDS_BYTES, stream);
        if (e != hipSuccess) fprintf(stderr, "cooperative launch failed: %s (grid %d)\n", hipGetErrorString(e), grid);
    } else {
        for (int p = 0; p < NPHASE; ++p) { a.ph_lo = p; a.ph_hi = p + 1; hipLaunchKernelGGL(mk_fwd, dim3(grid), dim3(512), LDS_BYTES, stream, a); }
    }
}
```

```cpp
#include <hip/hip_runtime.h>
#include <hip/hip_cooperative_groups.h>
#include <cstdint>
#include <cstdio>
namespace cg = cooperative_groups;

#define LAS __attribute__((address_space(3)))
typedef unsigned short bf16_t;
typedef short bf16x8 __attribute__((ext_vector_type(8)));
typedef float f32x4 __attribute__((ext_vector_type(4)));
typedef float f32x2 __attribute__((ext_vector_type(2)));
typedef float f32x16 __attribute__((ext_vector_type(16)));
typedef unsigned u32x4 __attribute__((ext_vector_type(4)));
typedef unsigned u32x2 __attribute__((ext_vector_type(2)));
typedef short v4i16_t __attribute__((ext_vector_type(4)));

#ifndef REP_GEMM
#define REP_GEMM 1
#endif
#ifndef REP_SCAN
#define REP_SCAN 1
#endif
#ifndef REP_ROWS
#define REP_ROWS 1
#endif
constexpr int DM = 1024, TP = 8192, BP = 4, BS = 8, TS = 64, PAST = 2048, NKS = PAST + TS;
constexpr int MP = BP * TP, MS = BS * TS, MT = MP + MS;
constexpr int RC = 1792, INC = 3336, NPAD = 3584, DFF = 2816;
constexpr float LOG2E = 1.4426950408889634f;
constexpr float QSCALE = 0.125f * LOG2E;
constexpr size_t O_Y = 0, O_STP = 34078720, O_SHP = 34209792, O_KP = 34216960, O_VP = 50994176, O_LFP = 67771392,
                 O_STS = 68033536, O_SHS = 68295680, O_KS = 68310016, O_VS = 68572160, O_LFS = 68834304;
constexpr size_t KiB = 1024, MiB = 1u << 20;
constexpr size_t WS_CTL = 0, WS_MOD = 1 * MiB, WS_RK = 2 * MiB, WS_LCP = 3 * MiB + 256 * KiB, WS_LCS = 4 * MiB + 512 * KiB;
constexpr size_t WS_WIN = 6 * MiB, WS_WO = 13 * MiB, WS_WGU = 15 * MiB, WS_WD = 26 * MiB, WS_WL = 31 * MiB + 512 * KiB;
constexpr size_t WS_XN = 33 * MiB, WS_PR = 98 * MiB, WS_A2 = 211 * MiB + 768 * KiB, WS_PF = 228 * MiB;
constexpr size_t WS_WDEC = 341 * MiB + 768 * KiB, WS_AG = 406 * MiB + 768 * KiB, WS_KS = 471 * MiB + 768 * KiB, WS_VS = 488 * MiB + 256 * KiB;
constexpr size_t WS_END = 509 * MiB + 768 * KiB;
constexpr size_t WS_Y = WS_XN, WS_X1 = WS_PR, WS_ACT = WS_PF;
constexpr size_t WS_ACTG = WS_KS, WS_H2G = WS_A2;
static_assert(WS_PR + (size_t)MT * RC * 2 == WS_A2 && WS_A2 + (size_t)MT * 256 * 2 == WS_PF && WS_PF + (size_t)MT * RC * 2 == WS_WDEC, "ws map");
static_assert(WS_WDEC + (size_t)MT * 512 * 4 == WS_AG && WS_AG + (size_t)MT * 1024 * 2 == WS_KS && WS_X1 + (size_t)MT * 1024 * 4 == WS_PF, "ws map");
static_assert(WS_ACT + (size_t)MT * DFF * 2 == WS_AG && WS_XN + (size_t)MT * 1024 * 2 == WS_PR, "ws map");
constexpr int LDS_BYTES = 147456;

__device__ __forceinline__ float bflo(unsigned u) { return __uint_as_float(u << 16); }
__device__ __forceinline__ float bfhi(unsigned u) { return __uint_as_float(u & 0xffff0000u); }
__device__ __forceinline__ float bf1(bf16_t b) { return __uint_as_float(((unsigned)b) << 16); }
__device__ __forceinline__ unsigned f2bf(float f) { unsigned u = __float_as_uint(f); return (u + 0x7fffu + ((u >> 16) & 1u)) >> 16; }
__device__ __forceinline__ unsigned pk2(float lo, float hi) { return f2bf(lo) | (f2bf(hi) << 16); }
__device__ __forceinline__ void unpack8(u32x4 u, float* f) { f[0] = bflo(u.x); f[1] = bfhi(u.x); f[2] = bflo(u.y); f[3] = bfhi(u.y); f[4] = bflo(u.z); f[5] = bfhi(u.z); f[6] = bflo(u.w); f[7] = bfhi(u.w); }
__device__ __forceinline__ u32x4 pack8(const float* f) { u32x4 o; o.x = pk2(f[0], f[1]); o.y = pk2(f[2], f[3]); o.z = pk2(f[4], f[5]); o.w = pk2(f[6], f[7]); return o; }
__device__ __forceinline__ float sigmoidf_(float x) { return 1.0f / (1.0f + __expf(-x)); }
template <int CTRL> __device__ __forceinline__ float dppf(float x) { return __builtin_bit_cast(float, __builtin_amdgcn_update_dpp(0, __builtin_bit_cast(int, x), CTRL, 0xf, 0xf, true)); }
__device__ __forceinline__ float sum8(float v) { v += dppf<0xB1>(v); v += dppf<0x4E>(v); v += dppf<0x141>(v); return v; }
__device__ __forceinline__ float wave_sum(float v) {
    v += dppf<0xB1>(v); v += dppf<0x4E>(v); v += dppf<0x141>(v); v += dppf<0x140>(v); v += __shfl_xor(v, 16); v += __shfl_xor(v, 32); return v;
}
__device__ __forceinline__ float allsum16(float v) {
    v += dppf<0xB1>(v); v += dppf<0x4E>(v); v += dppf<0x141>(v); v += dppf<0x140>(v); return v;
}
__device__ __forceinline__ int batch_of_row(int m) { return m < MP ? (m >> 13) : 4 + ((m - MP) >> 6); }


__device__ __forceinline__ void cbar(unsigned* ctr, unsigned target) {
    asm volatile("s_waitcnt vmcnt(0)" ::: "memory");
    __syncthreads();
    if (threadIdx.x == 0) {
        __builtin_amdgcn_fence(__ATOMIC_RELEASE, "agent");
        asm volatile("s_waitcnt vmcnt(0)" ::: "memory");
        __hip_atomic_fetch_add(ctr, 1u, __ATOMIC_RELAXED, __HIP_MEMORY_SCOPE_AGENT);
        while (__hip_atomic_load(ctr, __ATOMIC_RELAXED, __HIP_MEMORY_SCOPE_AGENT) < target) __builtin_amdgcn_s_sleep(2);
        __builtin_amdgcn_fence(__ATOMIC_ACQUIRE, "agent");
        asm volatile("s_waitcnt vmcnt(0)" ::: "memory");
    }
    __syncthreads();
}

#define XB_TMO      128
#define XB_XCNT(j)  (256  + 64 * (j))
#define XB_XSUB(j)  (1280 + 64 * (j))
#define XB_XGEN(j)  (2304 + 64 * (j))
#define XB_TOP      3328
#define XB_TOPGEN   3392
#define XCD_BAR_WORDS 3456
#define XB_SPIN_CAP (1u << 22)
__device__ __forceinline__ unsigned xb_ld(unsigned* p)              { return __hip_atomic_load(p, __ATOMIC_RELAXED, __HIP_MEMORY_SCOPE_AGENT); }
__device__ __forceinline__ unsigned xb_add(unsigned* p, unsigned v) { return __hip_atomic_fetch_add(p, v, __ATOMIC_RELAXED, __HIP_MEMORY_SCOPE_AGENT); }
__device__ __forceinline__ unsigned xb_xcc_id() { return (unsigned)__builtin_amdgcn_s_getreg((3 << 11) | 20) & 0xFu; }
#define XB_SPIN(cond, bar) do { unsigned _sp = 0; while (cond) { __builtin_amdgcn_s_sleep(1); \
    if ((++_sp & 255u) == 0u) { if (xb_ld(&(bar)[XB_TMO])) break; if (_sp > XB_SPIN_CAP) { atomicAdd(&(bar)[XB_TMO], 1u); break; } } } } while (0)
struct XcdBarrier { unsigned* bar; unsigned x; volatile LAS unsigned* st; };
__device__ __forceinline__ XcdBarrier xcd_barrier_post(unsigned* bar, volatile LAS unsigned* st) {
    XcdBarrier b; b.bar = bar; b.x = xb_xcc_id(); b.st = st;
    if (threadIdx.x == 0) (void)xb_add(&bar[XB_XCNT(b.x)], 1u);
    return b;
}
__device__ __forceinline__ void xcd_barrier_complete(unsigned* bar, unsigned x, unsigned& nloc, unsigned& nx) {
    const unsigned Gn = gridDim.x * gridDim.y * gridDim.z;
    unsigned sum, cnt, mine, sp = 0u;
    for (;;) {
        sum = 0u; cnt = 0u; mine = 0u;
#pragma unroll
        for (unsigned j = 0; j < 16; ++j) { const unsigned c = xb_ld(&bar[XB_XCNT(j)]); sum += c; cnt += (c > 0u) ? 1u : 0u; mine = (j == x) ? c : mine; }
        if (sum == Gn) break;
        __builtin_amdgcn_s_sleep(1);
        if ((++sp & 255u) == 0u) { if (xb_ld(&bar[XB_TMO])) break; if (sp > XB_SPIN_CAP) { atomicAdd(&bar[XB_TMO], 1u); break; } }
    }
    nloc = mine > 0u ? mine : 1u; nx = cnt > 0u ? cnt : 1u;
}
__device__ __forceinline__ void xcd_barrier(const XcdBarrier& b, bool first) {
    asm volatile("s_waitcnt vmcnt(0)" ::: "memory");
    __syncthreads();
    if (threadIdx.x == 0) {
        unsigned* bar = b.bar;
        __builtin_amdgcn_s_waitcnt(0);
        unsigned nloc = first ? 0u : b.st[0], nx = first ? 0u : b.st[1];
        if (first) (void)xb_add(&bar[XB_XCNT(b.x)], 1u);
        if (nloc == 0u) { xcd_barrier_complete(bar, b.x, nloc, nx); b.st[0] = nloc; b.st[1] = nx; }
        const unsigned old = xb_add(&bar[XB_XSUB(b.x)], 1u);
        const unsigned gen = old / nloc;
        if (old + 1u == (gen + 1u) * nloc) {
            __builtin_amdgcn_fence(__ATOMIC_RELEASE, "agent");
            asm volatile("s_waitcnt vmcnt(0)" ::: "memory");
            const unsigned og = xb_add(&bar[XB_TOP], 1u);
            const unsigned tg = og / nx;
            if (og + 1u == (tg + 1u) * nx) xb_add(&bar[XB_TOPGEN], 1u);
            else XB_SPIN(xb_ld(&bar[XB_TOPGEN]) == tg, bar);
            __builtin_amdgcn_fence(__ATOMIC_ACQUIRE, "agent");
            xb_add(&bar[XB_XGEN(b.x)], 1u);
            asm volatile("s_waitcnt vmcnt(0)" ::: "memory");
        } else {
            XB_SPIN(xb_ld(&bar[XB_XGEN(b.x)]) == gen, bar);
            __builtin_amdgcn_fence(__ATOMIC_ACQUIRE, "agent");
            asm volatile("s_waitcnt vmcnt(0)" ::: "memory");
        }
    }
    __syncthreads();
}

namespace pg8 {
constexpr int BM = 256, BK = 64, HALF = 128, HTB = HALF * BK * 2, STAGE_BYTES = 8 * HTB, NXCD = 8, WGM = 8;
__host__ __device__ __forceinline__ int lds_byte(int r, int c) { const int st = (r >> 4) * 2 + (c >> 5), rr = r & 15, cc = c & 31, ob = rr * 64 + cc * 2; return st * 1024 + (ob ^ (((ob >> 9) & 1) << 5)); }
__host__ __device__ __forceinline__ void stage_rc(int b, int& R, int& C) { const int st = b / 1024, sb = b % 1024, swz = sb ^ (((sb >> 9) & 1) << 5); R = (st >> 1) * 16 + swz / 64; C = (st & 1) * 32 + (swz % 64) / 2; }
__host__ __device__ __forceinline__ int perm32(int rho) { const int n = rho >> 4, i = rho & 15; return 8 * (i >> 2) + 4 * n + (i & 3); }
struct Unit { int pm, pn, pg, pb; };
struct Gemm { const bf16_t* A; const bf16_t* Bt; int M, N, K, lda; };
struct StaticOrder {
    int nM, nN, nwg, G, c;
    __device__ void init(int M, int N, int G_, int c_) { nM = M / BM; nN = N / BM; nwg = nM * nN; G = G_; c = c_; }
    __device__ bool next(int i, Unit& u) const {
        const long L = (long)i * G + c; if (L >= (long)nwg * REP_GEMM) return false;
        int wgid = (int)(L % nwg); { const int q = nwg / NXCD, r = nwg % NXCD, xcd = wgid % NXCD, off = wgid / NXCD; wgid = (xcd < r ? xcd * (q + 1) : r * (q + 1) + (xcd - r) * q) + off; }
        const int nig = WGM * nN, gid = wgid / nig, fm = gid * WGM, gsz = (nM - fm) < WGM ? (nM - fm) : WGM;
        u.pm = fm + ((wgid % nig) % gsz); u.pn = (wgid % nig) / gsz; u.pg = u.pm; u.pb = u.pm; return true;
    }
};

struct RowSet {
    int rest, g;
    __device__ __forceinline__ int ntiles() const { return MT / 256; }
    __device__ __forceinline__ int nrows() const { return MT; }
    __device__ __forceinline__ int gtile(int rt) const { return rt; }
    __device__ __forceinline__ int grow(int r) const { return r; }
    __device__ __forceinline__ int brow(int r) const { return r; }
};
struct MapOrder {
    RowSet rs; int nN, pool, rank, a_global;
    __device__ bool next(int i, Unit& u) const {
        const int L = i * pool + rank; if (L >= rs.ntiles() * nN) return false;
        const int rt = L / nN; u.pn = L % nN; u.pg = rs.gtile(rt); u.pb = u.pg; u.pm = a_global ? u.pg : u.pb; return true;
    }
};
__device__ __forceinline__ unsigned cvt_pk_bf16(float lo, float hi) { unsigned r; asm volatile("v_cvt_pk_bf16_f32 %0, %1, %2" : "=v"(r) : "v"(lo), "v"(hi)); return r; }

struct EpiProj {
    static constexpr bool PERM = true;
    bf16_t* PR; bf16_t* PF;
    __device__ __forceinline__ void operator()(const f32x4 (&acc)[2][2][4][2], const Unit& u, int wr, int wc, int fr, int fq) const {
        int colt = u.pn * BM; bf16_t* base = PR; if (colt >= RC) { base = PF; colt -= RC; }
        const int row0 = u.pm * BM + wr * 64 + fr, col0 = colt + wc * 32 + 8 * fq;
#pragma unroll
        for (int ai = 0; ai < 2; ++ai)
#pragma unroll
            for (int m = 0; m < 4; ++m) { bf16_t* rowp = base + (size_t)(row0 + ai * HALF + m * 16) * RC + col0;
#pragma unroll
                for (int bj = 0; bj < 2; ++bj) { const f32x4 v0 = acc[ai][bj][m][0], v1 = acc[ai][bj][m][1]; u32x4 w;
                    w.x = cvt_pk_bf16(v0[0], v0[1]); w.y = cvt_pk_bf16(v0[2], v0[3]); w.z = cvt_pk_bf16(v1[0], v1[1]); w.w = cvt_pk_bf16(v1[2], v1[3]);
                    *(u32x4*)(rowp + bj * HALF) = w; } }
    }
};
struct EpiLora {
    static constexpr bool PERM = false;
    float* Wdec; bf16_t* AG; const float* w0; const float* a0;
    __device__ __forceinline__ void operator()(const f32x4 (&acc)[2][2][4][2], const Unit& u, int wr, int wc, int fr, int fq) const {
        const int type = u.pn >> 1, cbase = (u.pn & 1) * BM + wc * 32 + 4 * fq, row0 = u.pm * BM + wr * 64 + fr;
#pragma unroll
        for (int bj = 0; bj < 2; ++bj)
#pragma unroll
            for (int n = 0; n < 2; ++n) { const int ch = cbase + bj * HALF + n * 16;
                f32x4 bias = (f32x4){0.f, 0.f, 0.f, 0.f};
                if (type == 0) bias = *(const f32x4*)(w0 + ch); else if (type == 1) bias = *(const f32x4*)(a0 + ch);
#pragma unroll
                for (int ai = 0; ai < 2; ++ai)
#pragma unroll
                    for (int m = 0; m < 4; ++m) { const size_t row = (size_t)(row0 + ai * HALF + m * 16); f32x4 v = acc[ai][bj][m][n] + bias;
                        if (type == 0) { f32x4 o;
#pragma unroll
                            for (int j = 0; j < 4; ++j) o[j] = __expf(-0.6065306597126334f * sigmoidf_(v[j]));
                            *(f32x4*)(Wdec + row * 512 + ch) = o; }
                        else { if (type == 1) {
#pragma unroll
                                for (int j = 0; j < 4; ++j) v[j] = sigmoidf_(v[j]); }
                            u32x2 w; w.x = cvt_pk_bf16(v[0], v[1]); w.y = cvt_pk_bf16(v[2], v[3]);
                            *(u32x2*)(AG + row * 1024 + (type == 2 ? 512 : 0) + ch) = w; } } }
    }
};
struct EpiResid {
    static constexpr bool PERM = false;
    const float* base_p; const float* base_s; const float* base_buf; float* out_final; float* out_buf; const float* gate;
    __device__ __forceinline__ void operator()(const f32x4 (&acc)[2][2][4][2], const Unit& u, int wr, int wc, int fr, int fq) const {
        const int col0 = u.pn * BM + wc * 32 + 4 * fq;
#pragma unroll
        for (int ai = 0; ai < 2; ++ai)
#pragma unroll
            for (int m = 0; m < 4; ++m) { const int rl = ai * HALF + wr * 64 + m * 16 + fr, row = u.pg * BM + rl, rowb = u.pb * BM + rl;
                const float* bp = (base_buf ? base_buf + (size_t)rowb * DM : (row < MP ? base_p + (size_t)row * DM : base_s + (size_t)(row - MP) * DM)) + col0;
                const float* gp = gate + (size_t)batch_of_row(row) * 6144 + col0; float* op = (out_final ? out_final + (size_t)row * DM : out_buf + (size_t)rowb * DM) + col0;
#pragma unroll
                for (int bj = 0; bj < 2; ++bj)
#pragma unroll
                    for (int n = 0; n < 2; ++n) { const int o = bj * HALF + n * 16; const f32x4 b = *(const f32x4*)(bp + o), g = *(const f32x4*)(gp + o);
                        *(f32x4*)(op + o) = b + g * acc[ai][bj][m][n]; } }
    }
};
struct EpiSwiglu {
    static constexpr bool PERM = true;
    bf16_t* ACT;
    __device__ __forceinline__ void operator()(const f32x4 (&acc)[2][2][4][2], const Unit& u, int wr, int wc, int fr, int fq) const {
        const int row0 = u.pb * BM + wr * 64 + fr, col0 = u.pn * HALF + wc * 32 + 8 * fq;
#pragma unroll
        for (int ai = 0; ai < 2; ++ai)
#pragma unroll
            for (int m = 0; m < 4; ++m) { float r[8];
#pragma unroll
                for (int n = 0; n < 2; ++n)
#pragma unroll
                    for (int j = 0; j < 4; ++j) { const float g = acc[ai][0][m][n][j], up = acc[ai][1][m][n][j]; r[n * 4 + j] = g * __builtin_amdgcn_rcpf(1.0f + __expf(-g)) * up; }
                u32x4 w; w.x = cvt_pk_bf16(r[0], r[1]); w.y = cvt_pk_bf16(r[2], r[3]); w.z = cvt_pk_bf16(r[4], r[5]); w.w = cvt_pk_bf16(r[6], r[7]);
                *(u32x4*)(ACT + (size_t)(row0 + ai * HALF + m * 16) * DFF + col0) = w; }
    }
};

template <class Epi, class Sched, bool ALIGN_EPI>
__device__ __forceinline__ void gemm_phase(LAS unsigned char* lds, const Gemm g, const Sched& S, const Epi& E, int opq = 0) {
    const int tid = threadIdx.x + opq, wid = __builtin_amdgcn_readfirstlane(tid >> 6), lane = tid & 63, wr = wid >> 2, wc = wid & 3, fr = lane & 15, fq = lane >> 4;
    const int K = g.K, nt = K / BK, lda = g.lda;
    unsigned voffA[2], voffB[2];
#pragma unroll
    for (int i = 0; i < 2; ++i) { int R, C; stage_rc(tid * 16 + i * 8192, R, C); const int Rb = Epi::PERM ? ((R & ~31) + perm32(R & 31)) : R;
        voffA[i] = (unsigned)(R * lda + C) * 2u; voffB[i] = (unsigned)(Rb * K + C) * 2u; }
    const size_t kstep = (size_t)(BK * 2);
    const size_t hstepA = (size_t)HALF * lda * 2, hstepB = (size_t)HALF * K * 2;
    const size_t tstepA = 2 * hstepA, tstepB = 2 * hstepB;
    const unsigned ldsw = (unsigned)wid * 1024u;
    const int aoff = lds_byte(wr * 64 + fr, fq * 8), boff = lds_byte(wc * 32 + fr, fq * 8);
#define PG8_SA(b, h) (((b) * 2 + (h)) * HTB)
#define PG8_SB(b, h) ((4 + (b) * 2 + (h)) * HTB)
#define PG8_STAGE(bufoff, gbase, voff) do { _Pragma("unroll") for (int _i = 0; _i < 2; ++_i) \
        __builtin_amdgcn_global_load_lds((const unsigned*)((const char*)(gbase) + (voff)[_i]), (LAS unsigned*)(lds + (bufoff) + ldsw + _i * 8192), 16, 0, 0); } while (0)
#define PG8_LDA(dst, b, h) do { _Pragma("unroll") for (int m = 0; m < 4; ++m) _Pragma("unroll") for (int k = 0; k < 2; ++k) dst[m][k] = *(const LAS bf16x8*)(lds + PG8_SA(b, h) + aoff + m * 2048 + k * 1024); } while (0)
#define PG8_LDB(dst, b, h) do { _Pragma("unroll") for (int n = 0; n < 2; ++n) _Pragma("unroll") for (int k = 0; k < 2; ++k) dst[n][k] = *(const LAS bf16x8*)(lds + PG8_SB(b, h) + boff + n * 2048 + k * 1024); } while (0)
#define PG8_MMA(ai, bj, At, Bt) do { __builtin_amdgcn_s_setprio(1); _Pragma("unroll") for (int m = 0; m < 4; ++m) _Pragma("unroll") for (int n = 0; n < 2; ++n) _Pragma("unroll") for (int k = 0; k < 2; ++k) \
        acc[ai][bj][m][n] = __builtin_amdgcn_mfma_f32_16x16x32_bf16(Bt[n][k], At[m][k], acc[ai][bj][m][n], 0, 0, 0); __builtin_amdgcn_s_setprio(0); } while (0)
#define PG8_WAIT_V(n) asm volatile("s_waitcnt vmcnt(" #n ")" ::: "memory")
#define PG8_WAIT_L(n) asm volatile("s_waitcnt lgkmcnt(" #n ")" ::: "memory")
#define PG8_BAR __builtin_amdgcn_s_barrier()
#define PG8_SCHED __builtin_amdgcn_sched_barrier(0)
    Unit cur, nxt; int ui = 0;
    if (!S.next(0, cur)) return;
    f32x4 acc[2][2][4][2];
#pragma unroll
    for (int a = 0; a < 2; ++a)
#pragma unroll
        for (int b = 0; b < 2; ++b)
#pragma unroll
            for (int m = 0; m < 4; ++m)
#pragma unroll
                for (int n = 0; n < 2; ++n) acc[a][b][m][n] = (f32x4){0.f, 0.f, 0.f, 0.f};
    bf16x8 At[4][2], B0[2][2], B1[2][2];
    const char* cA = (const char*)g.A + (size_t)cur.pm * tstepA; const char* cB = (const char*)g.Bt + (size_t)cur.pn * tstepB;
    PG8_STAGE(PG8_SB(0, 0), cB, voffB); PG8_STAGE(PG8_SB(0, 1), cB + hstepB, voffB); PG8_STAGE(PG8_SA(0, 0), cA, voffA); PG8_STAGE(PG8_SA(0, 1), cA + hstepA, voffA);
    if (wr == 1) PG8_BAR;
    PG8_WAIT_V(2); PG8_BAR;
    PG8_STAGE(PG8_SB(1, 0), cB + kstep, voffB); PG8_STAGE(PG8_SA(1, 0), cA + kstep, voffA); PG8_STAGE(PG8_SB(1, 1), cB + hstepB + kstep, voffB);
    PG8_WAIT_V(6); PG8_BAR;
    for (;;) {
        const bool has_next = S.next(ui + 1, nxt);
        const char* nA = has_next ? (const char*)g.A + (size_t)nxt.pm * tstepA : cA; const char* nB = has_next ? (const char*)g.Bt + (size_t)nxt.pn * tstepB : cB;
        for (int t = 0; t < nt; t += 2) {
            const bool last = (t == nt - 2);
            const char* a1 = cA + (size_t)(t + 1) * kstep;
            const char* a2 = last ? nA : cA + (size_t)(t + 2) * kstep; const char* b2 = last ? nB : cB + (size_t)(t + 2) * kstep;
            const char* a3 = a2 + kstep; const char* b3 = b2 + kstep;
            PG8_LDB(B0, 0, 0); PG8_LDB(B1, 0, 1); PG8_SCHED; PG8_LDA(At, 0, 0); PG8_STAGE(PG8_SA(1, 1), a1 + hstepA, voffA);
            PG8_WAIT_V(8); PG8_WAIT_L(0); PG8_BAR; PG8_MMA(0, 0, At, B0); PG8_MMA(0, 1, At, B1); PG8_BAR; PG8_SCHED;
            PG8_LDA(At, 0, 1); PG8_STAGE(PG8_SB(0, 0), b2, voffB); PG8_STAGE(PG8_SB(0, 1), b2 + hstepB, voffB); PG8_STAGE(PG8_SA(0, 0), a2, voffA);
            PG8_WAIT_V(8); PG8_WAIT_L(0); PG8_BAR; PG8_MMA(1, 0, At, B0); PG8_MMA(1, 1, At, B1); PG8_BAR; PG8_SCHED;
            PG8_LDB(B0, 1, 0); PG8_LDB(B1, 1, 1); PG8_SCHED; PG8_LDA(At, 1, 0); PG8_STAGE(PG8_SA(0, 1), a2 + hstepA, voffA);
            PG8_WAIT_V(8); PG8_WAIT_L(0); PG8_BAR; PG8_MMA(0, 0, At, B0); PG8_MMA(0, 1, At, B1); PG8_BAR; PG8_SCHED;
            PG8_LDA(At, 1, 1); PG8_STAGE(PG8_SB(1, 0), b3, voffB); PG8_STAGE(PG8_SB(1, 1), b3 + hstepB, voffB); PG8_STAGE(PG8_SA(1, 0), a3, voffA);
            PG8_WAIT_V(8); PG8_WAIT_L(0); PG8_BAR; PG8_MMA(1, 0, At, B0); PG8_MMA(1, 1, At, B1); PG8_BAR; PG8_SCHED;
        }
        if constexpr (ALIGN_EPI) { if (wr == 0) PG8_BAR; }
        E(acc, cur, wr, wc, fr, fq);
        if (!has_next) break;
#pragma unroll
        for (int a = 0; a < 2; ++a)
#pragma unroll
            for (int b = 0; b < 2; ++b)
#pragma unroll
                for (int m = 0; m < 4; ++m)
#pragma unroll
                    for (int n = 0; n < 2; ++n) acc[a][b][m][n] = (f32x4){0.f, 0.f, 0.f, 0.f};
        cur = nxt; cA = nA; cB = nB; ++ui;
        if constexpr (ALIGN_EPI) { if (wr == 1) PG8_BAR; }
    }
    PG8_WAIT_V(0);
    if constexpr (!ALIGN_EPI) { if (wr == 0) PG8_BAR; }
    PG8_BAR;
#undef PG8_SA
#undef PG8_SB
#undef PG8_STAGE
#undef PG8_LDA
#undef PG8_LDB
#undef PG8_MMA
#undef PG8_WAIT_V
#undef PG8_WAIT_L
#undef PG8_BAR
#undef PG8_SCHED
}
}

struct Args { const float* in[32]; float* out; unsigned char* ws; int ph_lo, ph_hi; };

struct SrcPlain { const float* W; int ld, nvalid; __device__ __forceinline__ float operator()(int k, int n) const { return n < nvalid ? W[(size_t)k * ld + n] : 0.f; } };
struct SrcRot { const float* W; __device__ __forceinline__ float operator()(int k, int n) const { return W[(size_t)((k + 512) & 1023) * 1024 + n]; } };
struct SrcLora { const float* wd; const float* wa; const float* wg;
    __device__ __forceinline__ float operator()(int k, int n) const {
        if (n < 512) return k < 64 ? wd[k * 512 + n] : 0.f;
        if (n < 1024) return (k >= 64 && k < 128) ? wa[(k - 64) * 512 + (n - 512)] : 0.f;
        return k >= 128 ? wg[(k - 128) * 512 + (n - 1024)] : 0.f; } };
struct DstId { __device__ __forceinline__ int operator()(int n) const { return n; } };
struct DstGU { int add; __device__ __forceinline__ int operator()(int n) const { return (n >> 7) * 256 + (n & 127) + add; } };
template <class SrcF, class DstF>
__device__ __forceinline__ void tr_item(const SrcF& src, const DstF& drow, bf16_t* WT, int ldt, int k0, int n0, LAS float* scr, int lane) {
#pragma unroll 8
    for (int i = 0; i < 32; ++i) { const int kk = 2 * i + (lane >> 5); scr[kk * 33 + (lane & 31)] = src(k0 + kk, n0 + (lane & 31)); }
    asm volatile("s_waitcnt lgkmcnt(0)" ::: "memory");
    const int c = lane & 7;
#pragma unroll
    for (int j = 0; j < 4; ++j) { const int n = (lane >> 3) + 8 * j; const LAS float* s = scr + (8 * c) * 33 + n;
        u32x4 o; o.x = pk2(s[0 * 33], s[1 * 33]); o.y = pk2(s[2 * 33], s[3 * 33]); o.z = pk2(s[4 * 33], s[5 * 33]); o.w = pk2(s[6 * 33], s[7 * 33]);
        *(u32x4*)(WT + (size_t)drow(n0 + n) * ldt + k0 + 8 * c) = o; }
    asm volatile("s_waitcnt lgkmcnt(0)" ::: "memory");
}

__device__ __forceinline__ void phase0(const Args& a, LAS unsigned char* lds) {
    const int tid = threadIdx.x, lane = tid & 63, wid = tid >> 6, blk = blockIdx.x, G = gridDim.x;
    unsigned char* ws = a.ws;
    if (blk < 96) {
        LAS float* sc = (LAS float*)lds;
        LAS float* red = (LAS float*)(lds + 49152);
        for (int i = tid; i < 12 * 1024; i += 512) { const int r = i >> 10, k = i & 1023; const float c = r < 4 ? a.in[7][r * 1024 + k] : a.in[8][(r - 4) * 1024 + k]; sc[k * 12 + r] = c * sigmoidf_(c); }
        __syncthreads();
        float acc[12];
#pragma unroll
        for (int r = 0; r < 12; ++r) acc[r] = 0.f;
        const float* wp = a.in[10] + (size_t)(wid * 128) * 6144 + blk * 64 + lane;
#pragma unroll 8
        for (int kk = 0; kk < 128; ++kk) { const float wv = wp[(size_t)kk * 6144]; const LAS f32x4* s = (const LAS f32x4*)(sc + (wid * 128 + kk) * 12);
            const f32x4 s0 = s[0], s1 = s[1], s2 = s[2];
            acc[0] += s0[0] * wv; acc[1] += s0[1] * wv; acc[2] += s0[2] * wv; acc[3] += s0[3] * wv; acc[4] += s1[0] * wv; acc[5] += s1[1] * wv;
            acc[6] += s1[2] * wv; acc[7] += s1[3] * wv; acc[8] += s2[0] * wv; acc[9] += s2[1] * wv; acc[10] += s2[2] * wv; acc[11] += s2[3] * wv; }
#pragma unroll
        for (int r = 0; r < 12; ++r) red[(wid * 12 + r) * 64 + lane] = acc[r];
        __syncthreads();
        float* mod = (float*)(ws + WS_MOD);
        for (int i = tid; i < 768; i += 512) { const int r = i >> 6, c = i & 63; float s = 0.f;
#pragma unroll
            for (int w = 0; w < 8; ++w) s += red[(w * 12 + r) * 64 + c];
            mod[r * 6144 + blk * 64 + c] = s + a.in[11][blk * 64 + c]; }
        __syncthreads();
    }
    {
        LAS float* scr = (LAS float*)(lds + wid * 16384);
        const int gw = blk * 8 + wid, NGW = G * 8;
        constexpr int I_IN = 16 * 112, I_O = 16 * 32, I_G = 16 * 88, I_D = 44 * 32, I_L = 4 * 48;
        constexpr int NITEMS = I_IN + I_O + 2 * I_G + I_D + I_L;
        for (int it = gw; it < NITEMS; it += NGW) {
            int r = it;
            if (r < I_IN) { tr_item(SrcPlain{a.in[12], INC, INC}, DstId{}, (bf16_t*)(ws + WS_WIN), 1024, (r / 112) * 64, (r % 112) * 32, scr, lane); continue; } r -= I_IN;
            if (r < I_O) { tr_item(SrcRot{a.in[27]}, DstId{}, (bf16_t*)(ws + WS_WO), 1024, (r / 32) * 64, (r % 32) * 32, scr, lane); continue; } r -= I_O;
            if (r < I_G) { tr_item(SrcPlain{a.in[29], DFF, DFF}, DstGU{0}, (bf16_t*)(ws + WS_WGU), 1024, (r / 88) * 64, (r % 88) * 32, scr, lane); continue; } r -= I_G;
            if (r < I_G) { tr_item(SrcPlain{a.in[30], DFF, DFF}, DstGU{128}, (bf16_t*)(ws + WS_WGU), 1024, (r / 88) * 64, (r % 88) * 32, scr, lane); continue; } r -= I_G;
            if (r < I_D) { tr_item(SrcPlain{a.in[31], 1024, 1024}, DstId{}, (bf16_t*)(ws + WS_WD), DFF, (r / 32) * 64, (r % 32) * 32, scr, lane); continue; } r -= I_D;
            tr_item(SrcLora{a.in[15], a.in[17], a.in[18]}, DstId{}, (bf16_t*)(ws + WS_WL), 256, (r / 48) * 64, (r % 48) * 32, scr, lane);
        }
    }
    {
        const int gt = blk * 512 + tid, NGT = G * 512;
        for (int gidx = gt; gidx < 2 * 1048576; gidx += NGT) {
            const int which = gidx >> 20, g8 = gidx & 1048575; const size_t e = (size_t)g8 * 8; const int b = (int)(e >> 20); const size_t rem = e & 1048575;
            const float* src = (which ? a.in[3] : a.in[2]) + e; const f32x4 v0 = *(const f32x4*)src, v1 = *(const f32x4*)(src + 4);
            u32x4 o; o.x = pk2(v0[0], v0[1]); o.y = pk2(v0[2], v0[3]); o.z = pk2(v1[0], v1[1]); o.w = pk2(v1[2], v1[3]);
            bf16_t* dst = (bf16_t*)(ws + (which ? WS_VS : WS_KS)) + (size_t)b * NKS * 512 + rem; *(u32x4*)dst = o;
        }
    }
}

__device__ __forceinline__ void norm_rows(const float* xp, const float* xs, const float* gvec, const float* mod, int sh_off, int sc_off, bf16_t* XN) {
    const int lane = threadIdx.x & 63, gw = blockIdx.x * 8 + (threadIdx.x >> 6), NGW = gridDim.x * 8;
    f32x4 nx[4];
    auto ldrow = [&](int m) { const float* xr = (m < MP ? xp + (size_t)m * DM : xs + (size_t)(m - MP) * DM);
#pragma unroll
        for (int j = 0; j < 4; ++j) nx[j] = *(const f32x4*)(xr + 4 * lane + 256 * j); };
    if (gw < MT) ldrow(gw);
    for (int m = gw; m < MT; m += NGW) {
        const float* mr = mod + (size_t)batch_of_row(m) * 6144;
        f32x4 v[4]; float s = 0.f;
#pragma unroll
        for (int j = 0; j < 4; ++j) { v[j] = nx[j]; s += (v[j][0] * v[j][0] + v[j][1] * v[j][1]) + (v[j][2] * v[j][2] + v[j][3] * v[j][3]); }
        if (m + NGW < MT) ldrow(m + NGW);
        const float rinv = rsqrtf(wave_sum(s) * (1.f / DM) + 1e-6f);
#pragma unroll
        for (int j = 0; j < 4; ++j) { const int c = 4 * lane + 256 * j; const f32x4 g = *(const f32x4*)(gvec + c), sc = *(const f32x4*)(mr + sc_off + c), sh = *(const f32x4*)(mr + sh_off + c);
            f32x4 o;
#pragma unroll
            for (int q = 0; q < 4; ++q) o[q] = v[j][q] * rinv * g[q] * (1.f + sc[q]) + sh[q];
            u32x2 w; w.x = pk2(o[0], o[1]); w.y = pk2(o[2], o[3]); *(u32x2*)(XN + (size_t)m * DM + c) = w; }
    }
}

__device__ __forceinline__ void phase3(const Args& a) {
    const int lane = threadIdx.x & 63, gw = blockIdx.x * 8 + (threadIdx.x >> 6), NGW = gridDim.x * 8;
    unsigned char* ws = a.ws;
    bf16_t* PR = (bf16_t*)(ws + WS_PR); bf16_t* PF = (bf16_t*)(ws + WS_PF); bf16_t* A2 = (bf16_t*)(ws + WS_A2);
    const float* mu = a.in[13];
    struct P3Regs { u32x2 pw, qw; u32x4 q, k, v; bf16_t fl; };
    P3Regs nx;
    auto ldrow = [&](int m) { const bf16_t* pr = PR + (size_t)m * RC; const bf16_t* pf = PF + (size_t)m * RC; const int c = 1536 + 4 * lane;
        nx.pw = *(const u32x2*)(pr + c); nx.qw = *(const u32x2*)(PR + (size_t)(m > 0 ? m - 1 : 0) * RC + c);
        nx.q = *(const u32x4*)(pf + 8 * lane); nx.k = *(const u32x4*)(pf + 512 + 8 * lane); nx.v = *(const u32x4*)(pf + 1024 + 8 * lane); nx.fl = pf[1536 + (lane & 7)]; };
    if (gw < MT) ldrow(gw);
    for (int m = gw; m < MT; m += NGW) {
        const bool samp = m >= MP; const int ml = samp ? m - MP : m; const int b = samp ? (ml >> 6) : (ml >> 13); const int t = samp ? (ml & 63) : (ml & 8191);
        const bf16_t* pr = PR + (size_t)m * RC; bf16_t* pf = PF + (size_t)m * RC;
        const P3Regs cu = nx;
        if (m + NGW < MT) ldrow(m + NGW);
        {
            const int c = 1536 + 4 * lane; const u32x2 pw = cu.pw; float p[4] = {bflo(pw.x), bfhi(pw.x), bflo(pw.y), bfhi(pw.y)}; float pp[4];
            if (t > 0) { const u32x2 qw = cu.qw; pp[0] = bflo(qw.x); pp[1] = bfhi(qw.x); pp[2] = bflo(qw.y); pp[3] = bfhi(qw.y); }
            else if (samp) { const f32x4 q = *(const f32x4*)(a.in[6] + (size_t)b * RC + c); pp[0] = q[0]; pp[1] = q[1]; pp[2] = q[2]; pp[3] = q[3]; }
            else { pp[0] = pp[1] = pp[2] = pp[3] = 0.f; }
            const f32x4 mv = *(const f32x4*)(mu + c); float z[4];
#pragma unroll
            for (int j = 0; j < 4; ++j) { const float zz = p[j] + (pp[j] - p[j]) * mv[j]; z[j] = lane < 16 ? tanhf(zz) : (lane < 32 ? zz : sigmoidf_(zz)); }
            u32x2 w; w.x = pk2(z[0], z[1]); w.y = pk2(z[2], z[3]); *(u32x2*)(A2 + (size_t)m * 256 + 4 * lane) = w;
        }
        {
            float q[8]; unpack8(cu.q, q); float ss = 0.f;
#pragma unroll
            for (int j = 0; j < 8; ++j) ss += q[j] * q[j];
            const float rinv = rsqrtf(sum8(ss) * (1.f / 64.f) + 1e-6f) * QSCALE; const float* g = a.in[24] + ((8 * lane) & 63);
#pragma unroll
            for (int j = 0; j < 8; ++j) q[j] = q[j] * rinv * g[j];
            *(u32x4*)(pf + 8 * lane) = pack8(q);
        }
        {
            float k[8]; unpack8(cu.k, k); float ss = 0.f;
#pragma unroll
            for (int j = 0; j < 8; ++j) ss += k[j] * k[j];
            const float rinv = rsqrtf(sum8(ss) * (1.f / 64.f) + 1e-6f); const float* g = a.in[25] + ((8 * lane) & 63);
#pragma unroll
            for (int j = 0; j < 8; ++j) k[j] = k[j] * rinv * g[j];
            const u32x4 kb = pack8(k); *(u32x4*)(pf + 512 + 8 * lane) = kb;
            float* ko = a.out + (samp ? O_KS : O_KP) + (size_t)ml * 512 + 8 * lane;
            *(f32x4*)ko = (f32x4){k[0], k[1], k[2], k[3]}; *(f32x4*)(ko + 4) = (f32x4){k[4], k[5], k[6], k[7]};
            if (samp) *(u32x4*)((bf16_t*)(ws + WS_KS) + ((size_t)b * NKS + PAST + t) * 512 + 8 * lane) = kb;
        }
        {
            const u32x4 vb = cu.v; float v[8]; unpack8(vb, v);
            float* vo = a.out + (samp ? O_VS : O_VP) + (size_t)ml * 512 + 8 * lane;
            *(f32x4*)vo = (f32x4){v[0], v[1], v[2], v[3]}; *(f32x4*)(vo + 4) = (f32x4){v[4], v[5], v[6], v[7]};
            if (samp) *(u32x4*)((bf16_t*)(ws + WS_VS) + ((size_t)b * NKS + PAST + t) * 512 + 8 * lane) = vb;
        }
        if (lane < 8) { const float x = bf1(cu.fl) + a.in[26][lane]; const float lf = fminf(x, 0.f) - log1pf(__expf(-fabsf(x)));
            a.out[(samp ? O_LFS : O_LFP) + (size_t)ml * 8 + lane] = lf; }
        if (t == (samp ? TS - 1 : TP - 1)) { float* so = a.out + (samp ? O_SHS : O_SHP) + (size_t)b * RC;
            for (int c = lane; c < RC; c += 64) so[c] = bf1(pr[c]); }
    }
}

__device__ __forceinline__ void cumsum_block(LAS unsigned char* lds, const float* srcA, int nA, const float* srcB, int ntot, int tpt, float* dst  ) {
    const int tid = threadIdx.x, lane = tid & 63, wid = tid >> 6;
    LAS double* part = (LAS double*)lds;
    const int t0 = tid * tpt; const bool act = t0 < ntot;
    float s[8];
#pragma unroll
    for (int h = 0; h < 8; ++h) s[h] = 0.f;
    if (act) for (int i = 0; i < tpt; ++i) { const int t = t0 + i; const float* p = t < nA ? srcA + (size_t)t * 8 : srcB + (size_t)(t - nA) * 8; const f32x4 v0 = *(const f32x4*)p, v1 = *(const f32x4*)(p + 4);
        s[0] += v0[0]; s[1] += v0[1]; s[2] += v0[2]; s[3] += v0[3]; s[4] += v1[0]; s[5] += v1[1]; s[6] += v1[2]; s[7] += v1[3]; }
#pragma unroll
    for (int h = 0; h < 8; ++h) part[h * 512 + tid] = (double)s[h];
    __syncthreads();
    {
        double v[8]; double run = 0.0;
#pragma unroll
        for (int i = 0; i < 8; ++i) { v[i] = part[wid * 512 + lane * 8 + i]; run += v[i]; }
        double incl = run;
#pragma unroll
        for (int o = 1; o < 64; o <<= 1) { const double y = __shfl_up(incl, o); if (lane >= o) incl += y; }
        double ex = incl - run;
#pragma unroll
        for (int i = 0; i < 8; ++i) { const double tmp = v[i]; part[wid * 512 + lane * 8 + i] = ex; ex += tmp; }
    }
    __syncthreads();
    if (act) { double r[8];
#pragma unroll
        for (int h = 0; h < 8; ++h) r[h] = part[h * 512 + tid];
        for (int i = 0; i < tpt; ++i) { const int t = t0 + i; const float* p = t < nA ? srcA + (size_t)t * 8 : srcB + (size_t)(t - nA) * 8; const f32x4 v0 = *(const f32x4*)p, v1 = *(const f32x4*)(p + 4);
            r[0] += v0[0]; r[1] += v0[1]; r[2] += v0[2]; r[3] += v0[3]; r[4] += v1[0]; r[5] += v1[1]; r[6] += v1[2]; r[7] += v1[3];
#pragma unroll
            for (int h = 0; h < 8; ++h) dst[(size_t)h * ntot + t] = (float)(r[h] * (double)LOG2E); } }
    __syncthreads();
}

constexpr int CL = 64, NCH = TP / CL, SA_ITEMS = 32 * NCH + 64;
constexpr int SA_G = 0, SA_NKM = 16384, SA_AKN = 33024, SA_ABT = 49664, SA_NT = 66048, SA_RT = 75264, SA_BQ = 84480, SA_KQ = 93696, SA_BHK = 102912, SA_KH = 112128,
              SA_ABRT = 121344, SA_AKRT = 130560, SA_GL = 139776, SA_TOT = 140032, SA_Z = SA_BQ, SA_NP = SA_KQ, SA_OUT = 0;
__device__ __forceinline__ f32x4 mm_tile(const LAS unsigned char* X, const LAS unsigned char* Y, int tm, int tn, int lane) {
    f32x4 acc = {0.f, 0.f, 0.f, 0.f};
#pragma unroll
    for (int ks = 0; ks < 2; ++ks) {
        const bf16x8 xa = *(const LAS bf16x8*)(X + (16 * tm + (lane & 15)) * 144 + (32 * ks + 8 * (lane >> 4)) * 2);
        const bf16x8 yb = *(const LAS bf16x8*)(Y + (16 * tn + (lane & 15)) * 144 + (32 * ks + 8 * (lane >> 4)) * 2);
        acc = __builtin_amdgcn_mfma_f32_16x16x32_bf16(xa, yb, acc, 0, 0, 0);
    }
    return acc;
}
template <int u> __device__ __forceinline__ void sub_step(f32x2 (&xp)[32], const LAS float* A) {
    constexpr int G0 = (u + 1) / 4, NV = 16 - G0;
    f32x4 av[NV];
#pragma unroll
    for (int g = 0; g < NV; ++g) av[g] = *(const volatile LAS f32x4*)(A + u * 64 + 4 * (G0 + g));
#pragma unroll
    for (int g = 0; g < NV; ++g) {
        const f32x2 alo = {av[g][0], av[g][1]}, ahi = {av[g][2], av[g][3]};
        if constexpr ((u & 1) == 0)
            asm volatile("v_pk_fma_f32 %0, %2, %3, %0 op_sel_hi:[0,1,1]\n\tv_pk_fma_f32 %1, %2, %4, %1 op_sel_hi:[0,1,1]"
                         : "+v"(xp[2 * (G0 + g)]), "+v"(xp[2 * (G0 + g) + 1]) : "v"(xp[u >> 1]), "v"(alo), "v"(ahi));
        else
            asm volatile("v_pk_fma_f32 %0, %2, %3, %0 op_sel:[1,0,0] op_sel_hi:[1,1,1]\n\tv_pk_fma_f32 %1, %2, %4, %1 op_sel:[1,0,0] op_sel_hi:[1,1,1]"
                         : "+v"(xp[2 * (G0 + g)]), "+v"(xp[2 * (G0 + g) + 1]) : "v"(xp[u >> 1]), "v"(alo), "v"(ahi));
    }
    __builtin_amdgcn_sched_barrier(0);
}
template <int t0, int n> struct SubSteps { static __device__ __forceinline__ void run(f32x2 (&x)[32], const LAS float* A) { sub_step<t0>(x, A); SubSteps<t0 + 1, n - 1>::run(x, A); } };
template <int t0> struct SubSteps<t0, 0> { static __device__ __forceinline__ void run(f32x2 (&)[32], const LAS float*) {} };
struct SaRegs { u32x4 pr, pk, qr, qk, av; f32x4 w0, w1; };
__device__ __forceinline__ void sa_load(const Args& a, int item, SaRegs& R) {
    const int tid = threadIdx.x; unsigned char* ws = a.ws;
    const bf16_t* PR = (const bf16_t*)(ws + WS_PR); const float* WD = (const float*)(ws + WS_WDEC); const bf16_t* AG = (const bf16_t*)(ws + WS_AG);
    const bool samp = item >= 32 * NCH; const int bh = samp ? item - 32 * NCH : item >> 7, c = samp ? 0 : item & 127, b = bh >> 3, h = bh & 7;
    const int row0 = samp ? MP + b * TS : b * TP + c * CL; const int tl = tid >> 3, cgp = tid & 7, c0 = h * 64 + 8 * cgp, m = row0 + tl;
    const bf16_t* p = PR + (size_t)m * RC + c0; const bf16_t* q = PR + (size_t)(m > 0 ? m - 1 : 0) * RC + c0;
    R.pr = *(const u32x4*)p; R.pk = *(const u32x4*)(p + 512); R.qr = *(const u32x4*)q; R.qk = *(const u32x4*)(q + 512);
    R.av = *(const u32x4*)(AG + (size_t)m * 1024 + c0); const float* wp = WD + (size_t)m * 512 + c0; R.w0 = *(const f32x4*)wp; R.w1 = *(const f32x4*)(wp + 4);
}
__device__ __forceinline__ void sa_item(const Args& a, LAS unsigned char* lds, int item, const SaRegs& R, int prev_item) {
    const int tid = threadIdx.x, lane = tid & 63, wid = __builtin_amdgcn_readfirstlane(tid >> 6);
    unsigned char* ws = a.ws;
    const bf16_t* PR = (const bf16_t*)(ws + WS_PR); const float* WD = (const float*)(ws + WS_WDEC); const bf16_t* AG = (const bf16_t*)(ws + WS_AG); float* RK = (float*)(ws + WS_RK);
    const bool samp = item >= 32 * NCH; const int bh = samp ? item - 32 * NCH : item >> 7, c = samp ? 0 : item & 127, b = bh >> 3, h = bh & 7;
    const int row0 = samp ? MP + b * TS : b * TP + c * CL;
    const float* shift0 = samp ? a.in[6] + (size_t)b * RC : nullptr;
    LAS float* G = (LAS float*)(lds + SA_G); LAS float* GL = (LAS float*)(lds + SA_GL); LAS float* TOT = (LAS float*)(lds + SA_TOT);
    const int tl = tid >> 3, cgp = tid & 7, c0 = h * 64 + 8 * cgp, m = row0 + tl;
    float zr[8], nk[8], bb[8], kp[8];
    {
        float pr[8], pk[8], qr[8], qk[8], av[8];
        unpack8(R.pr, pr); unpack8(R.pk, pk); unpack8(R.qr, qr); unpack8(R.qk, qk); unpack8(R.av, av);
        const f32x4 w0 = R.w0, w1 = R.w1;
        if (c == 0 && tl == 0) {
#pragma unroll
            for (int j = 0; j < 8; ++j) { qr[j] = shift0 ? shift0[c0 + j] : 0.f; qk[j] = shift0 ? shift0[512 + c0 + j] : 0.f; }
        }
        const f32x4* m4 = (const f32x4*)(a.in[13] + c0); const f32x4 x0 = m4[0], x1 = m4[1], y0 = m4[128], y1 = m4[129];
        const f32x4* k4p = (const f32x4*)(a.in[19] + c0); const f32x4* a4p = (const f32x4*)(a.in[20] + c0); const f32x4* r4p = (const f32x4*)(a.in[21] + c0);
        const f32x4 kk0 = k4p[0], kk1 = k4p[1], ka0 = a4p[0], ka1 = a4p[1], rk0 = r4p[0], rk1 = r4p[1];
        float mur[8], muk[8], kkw[8], kaw[8], rkw[8];
#pragma unroll
        for (int j = 0; j < 4; ++j) { mur[j] = x0[j]; mur[4 + j] = x1[j]; muk[j] = y0[j]; muk[4 + j] = y1[j]; kkw[j] = kk0[j]; kkw[4 + j] = kk1[j]; kaw[j] = ka0[j]; kaw[4 + j] = ka1[j]; rkw[j] = rk0[j]; rkw[4 + j] = rk1[j]; }
        float zk[8], kk[8]; float ss = 0.f;
#pragma unroll
        for (int j = 0; j < 8; ++j) { zr[j] = pr[j] + (qr[j] - pr[j]) * mur[j]; zk[j] = pk[j] + (qk[j] - pk[j]) * muk[j]; kk[j] = zk[j] * kkw[j]; ss += kk[j] * kk[j]; }
        const float inv = 1.0f / fmaxf(sqrtf(sum8(ss)), 1e-12f); float rk = 0.f;
#pragma unroll
        for (int j = 0; j < 8; ++j) { const float kn = kk[j] * inv; nk[j] = -kn; bb[j] = kn * av[j]; kp[j] = zk[j] * (1.f + (av[j] - 1.f) * kaw[j]); rk += zr[j] * kp[j] * rkw[j]; }
        rk = sum8(rk);
        if (cgp == 0) RK[(size_t)m * 8 + h] = rk;
        *(LAS f32x4*)(G + tl * 64 + 8 * cgp) = w0; *(LAS f32x4*)(G + tl * 64 + 8 * cgp + 4) = w1;
    }
    __syncthreads();
    {
        const int k = tid & 63, part = tid >> 6; float run = 1.f; float g8[8];
#pragma unroll
        for (int i = 0; i < 8; ++i) g8[i] = G[(8 * part + i) * 64 + k];
#pragma unroll
        for (int i = 0; i < 8; ++i) { run *= g8[i]; g8[i] = run; }
        TOT[part * 64 + k] = run;
        __syncthreads();
        float tt[8];
#pragma unroll
        for (int p2 = 0; p2 < 8; ++p2) tt[p2] = TOT[p2 * 64 + k];
        float pre = 1.f;
#pragma unroll
        for (int p2 = 0; p2 < 8; ++p2) pre *= (p2 < part) ? tt[p2] : 1.f;
#pragma unroll
        for (int i = 0; i < 8; ++i) G[(8 * part + i) * 64 + k] = g8[i] * pre;
        if (part == 7) GL[k] = run * pre;
    }
    __syncthreads();
    {
        float nt[8], rt[8], bq[8], kq[8], bh8[8], kh8[8];
        const f32x4 gA = *(const LAS f32x4*)(G + tl * 64 + 8 * cgp), gB = *(const LAS f32x4*)(G + tl * 64 + 8 * cgp + 4), lA = *(const LAS f32x4*)(GL + 8 * cgp), lB = *(const LAS f32x4*)(GL + 8 * cgp + 4);
        const int tlp = tl > 0 ? tl - 1 : 0; const f32x4 pA = *(const LAS f32x4*)(G + tlp * 64 + 8 * cgp), pB = *(const LAS f32x4*)(G + tlp * 64 + 8 * cgp + 4);
#pragma unroll
        for (int j = 0; j < 8; ++j) { const float g = j < 4 ? gA[j & 3] : gB[j & 3], gp = tl > 0 ? (j < 4 ? pA[j & 3] : pB[j & 3]) : 1.f, gl = j < 4 ? lA[j & 3] : lB[j & 3], ig = __builtin_amdgcn_rcpf(g);
            nt[j] = gp * nk[j]; rt[j] = g * zr[j]; bq[j] = bb[j] * ig; kq[j] = kp[j] * ig; bh8[j] = bq[j] * gl; kh8[j] = kq[j] * gl; }
        *(LAS u32x4*)(lds + SA_NT + tl * 144 + cgp * 16) = pack8(nt); *(LAS u32x4*)(lds + SA_RT + tl * 144 + cgp * 16) = pack8(rt);
        *(LAS u32x4*)(lds + SA_BQ + tl * 144 + cgp * 16) = pack8(bq); *(LAS u32x4*)(lds + SA_KQ + tl * 144 + cgp * 16) = pack8(kq);
        *(LAS u32x4*)(lds + SA_KH + tl * 144 + cgp * 16) = pack8(kh8);
#pragma unroll
        for (int j = 0; j < 8; ++j) { const int k = 8 * cgp + j;
            ((LAS float*)(lds + SA_NKM))[k * 65 + tl] = nt[j]; ((LAS bf16_t*)(lds + SA_BHK))[k * 72 + tl] = (bf16_t)f2bf(bh8[j]); }
    }
    __syncthreads();
    {
        const int prod = wid >> 1, half = wid & 1;
        const LAS unsigned char* X = lds + ((prod & 1) ? SA_KQ : SA_BQ); const LAS unsigned char* Yb = lds + ((prod & 2) ? SA_RT : SA_NT);
        for (int ti = 0; ti < 8; ++ti) { const int tile = half * 8 + ti, tm = tile >> 2, tn = tile & 3;
            f32x4 acc = mm_tile(X, Yb, tm, tn, lane);
            const int s0 = 16 * tm + 4 * (lane >> 4), t = 16 * tn + (lane & 15);
#pragma unroll
            for (int r = 0; r < 4; ++r) { const int s = s0 + r; const bool keep = (prod & 2) ? (s <= t) : (s < t); if (!keep) acc[r] = 0.f; }
            if (prod == 0) { LAS float* o = (LAS float*)(lds + SA_ABT);
#pragma unroll
                for (int r = 0; r < 4; ++r) o[(s0 + r) * 64 + t] = acc[r]; }
            else if (prod == 1) { LAS float* o = (LAS float*)(lds + SA_AKN);
#pragma unroll
                for (int r = 0; r < 4; ++r) o[(s0 + r) * 65 + t] = acc[r]; }
            else { u32x2 w; w.x = pk2(acc[0], acc[1]); w.y = pk2(acc[2], acc[3]);
                *(LAS u32x2*)(lds + (prod == 2 ? SA_ABRT : SA_AKRT) + t * 144 + s0 * 2) = w; }
        }
    }
    if (prev_item >= 0) asm volatile("s_waitcnt vmcnt(0)" ::: "memory");
    __syncthreads();
    if (prev_item >= 0 && tid == 0) __hip_atomic_store((unsigned*)(ws + WS_CTL) + 1024 + prev_item, 1u, __ATOMIC_RELAXED, __HIP_MEMORY_SCOPE_AGENT);
    if (wid < 2) {
        const LAS float* rhs = (const LAS float*)(lds + (wid == 0 ? SA_AKN : SA_NKM)) + lane * 65; const LAS float* At = (const LAS float*)(lds + SA_ABT);
        f32x2 xp[32];
#pragma unroll
        for (int t = 0; t < 32; ++t) xp[t] = (f32x2){rhs[2 * t], rhs[2 * t + 1]};
        SubSteps<0, 63>::run(xp, At);
        LAS unsigned char* o = lds + (wid == 0 ? SA_Z : SA_NP) + lane * 144;
#pragma unroll
        for (int g8 = 0; g8 < 8; ++g8) { u32x4 w; w.x = pk2(xp[4 * g8][0], xp[4 * g8][1]); w.y = pk2(xp[4 * g8 + 1][0], xp[4 * g8 + 1][1]); w.z = pk2(xp[4 * g8 + 2][0], xp[4 * g8 + 2][1]); w.w = pk2(xp[4 * g8 + 3][0], xp[4 * g8 + 3][1]); *(LAS u32x4*)(o + g8 * 16) = w; }
    }
    __syncthreads();
    {
        const int prod = wid >> 1, half = wid & 1;
        const LAS unsigned char* X = lds + ((prod == 0 || prod == 3) ? SA_BHK : SA_ABRT); const LAS unsigned char* Yb = lds + ((prod < 2) ? SA_NP : SA_Z);
        LAS bf16_t* OUT = (LAS bf16_t*)(lds + SA_OUT);
        const int rbase = (prod == 0 || prod == 3) ? 64 : 0, cbase = (prod < 2) ? 0 : 64;
        for (int ti = 0; ti < 8; ++ti) { const int tile = half * 8 + ti, tm = tile >> 2, tn = tile & 3;
            f32x4 acc = mm_tile(X, Yb, tm, tn, lane);
            const int m0 = 16 * tm + 4 * (lane >> 4), n = 16 * tn + (lane & 15);
            const LAS bf16_t* ap = (const LAS bf16_t*)(lds + (prod == 1 ? SA_RT : prod == 2 ? SA_AKRT : SA_KH)) + (prod == 3 ? n * 72 + m0 : m0 * 72 + n);
            const int st = (prod == 3) ? 1 : 72;
            const bf16_t a0 = ap[0], a1 = ap[st], a2 = ap[2 * st], a3 = ap[3 * st]; const float gl = GL[n];
            float addv[4] = {bf1(a0), bf1(a1), bf1(a2), bf1(a3)};
            if (prod == 0) {
#pragma unroll
                for (int r = 0; r < 4; ++r) addv[r] = (m0 + r == n) ? gl : 0.f; }
#pragma unroll
            for (int r = 0; r < 4; ++r) OUT[(rbase + m0 + r) * 136 + cbase + n] = (bf16_t)f2bf(acc[r] + addv[r]); }
    }
    __syncthreads();
    {
        unsigned char* dst = (unsigned char*)(a.out + O_Y) + (size_t)item * 32768;
        u32x4 vv[4];
#pragma unroll
        for (int ps = 0; ps < 4; ++ps) { const int idx = ps * 512 + tid, row = idx >> 4, ch = idx & 15; vv[ps] = *(const LAS u32x4*)(lds + SA_OUT + row * 272 + ch * 16); }
#pragma unroll
        for (int ps = 0; ps < 4; ++ps) { const int idx = ps * 512 + tid, row = idx >> 4, ch = idx & 15; unsigned char* gp = dst + row * 256 + ch * 16;
            asm volatile("global_store_dwordx4 %0, %1, off sc1\n\ts_nop 1" :: "v"(gp), "v"(vv[ps]) : "memory"); }
    }
    __syncthreads();
}

constexpr int SB_A = 0, SB_B0 = 17408, SB_B1 = 17408 + 34816;
__device__ __forceinline__ void sb_chain(const Args& a, LAS unsigned char* lds, int item0, int nch, int row0, int h, const float* S0, float* Sout, const float* shift0) {
    const int tid = threadIdx.x, lane = tid & 63, wid = __builtin_amdgcn_readfirstlane(tid >> 6);
    unsigned char* ws = a.ws;
    const bf16_t* PR = (const bf16_t*)(ws + WS_PR); float* Y = (float*)(ws + WS_Y);
    LAS bf16_t* AI = (LAS bf16_t*)(lds + SB_A);
    const int tl = tid >> 3, cgp = tid & 7, c0 = 1024 + h * 64 + 8 * cgp;
    const f32x4 mv0 = *(const f32x4*)(a.in[13] + c0), mv1 = *(const f32x4*)(a.in[13] + c0 + 4);
    struct ChunkRegs { u32x4 b[4], pv, qv; };
    ChunkRegs r0, r1, r2, r3;
    auto load_chunk = [&](int c, ChunkRegs& R) {
        const unsigned char* src = (const unsigned char*)(a.out + O_Y) + (size_t)(item0 + c) * 32768;
#pragma unroll
        for (int ps = 0; ps < 4; ++ps) R.b[ps] = *(const u32x4*)(src + (ps * 512 + tid) * 16);
        const int m = row0 + c * CL + tl; R.pv = *(const u32x4*)(PR + (size_t)m * RC + c0); R.qv = *(const u32x4*)(PR + (size_t)(m > 0 ? m - 1 : 0) * RC + c0); };
    auto store_chunk = [&](int c, const ChunkRegs& R) {
        LAS unsigned char* B = lds + ((c & 1) ? SB_B1 : SB_B0);
#pragma unroll
        for (int ps = 0; ps < 4; ++ps) { const int idx = ps * 512 + tid, row = idx >> 4, ch = idx & 15; *(LAS u32x4*)(B + row * 272 + ch * 16) = R.b[ps]; }
        float pv[8], qv[8]; unpack8(R.pv, pv); unpack8(R.qv, qv);
        if (c == 0 && tl == 0) {
#pragma unroll
            for (int j = 0; j < 8; ++j) qv[j] = shift0 ? shift0[c0 + j] : 0.f; }
        const float mu[8] = {mv0[0], mv0[1], mv0[2], mv0[3], mv1[0], mv1[1], mv1[2], mv1[3]};
#pragma unroll
        for (int j = 0; j < 8; ++j) AI[(8 * cgp + j) * 136 + 64 + tl] = (bf16_t)f2bf(pv[j] + (qv[j] - pv[j]) * mu[j]); };
    for (int e = tid; e < 4096; e += 512) AI[(e >> 6) * 136 + (e & 63)] = S0 ? (bf16_t)f2bf(S0[e]) : (bf16_t)0;
    unsigned* flags = (unsigned*)(ws + WS_CTL) + 1024 + item0;
    int ready = 0;
#define SB_WAIT_BATCH() do { const int hi_ = (ready + 16 < nch) ? ready + 16 : nch; \
        if (tid == 0) { for (;;) { unsigned v_ = 1u; for (int k_ = ready; k_ < hi_; ++k_) { const unsigned f_ = __hip_atomic_load(flags + k_, __ATOMIC_RELAXED, __HIP_MEMORY_SCOPE_AGENT); v_ = f_ < v_ ? f_ : v_; } \
                if (v_ != 0u) break; __builtin_amdgcn_s_sleep(8); } \
            __builtin_amdgcn_fence(__ATOMIC_ACQUIRE, "agent"); asm volatile("s_waitcnt vmcnt(0)" ::: "memory"); } \
        ready = hi_; } while (0)
    SB_WAIT_BATCH();
    __syncthreads();
    load_chunk(0, r0); store_chunk(0, r0);
    if (nch > 1) load_chunk(1, r1);
    if (nch > 2) load_chunk(2, r2);
    if (nch > 3) load_chunk(3, r3);
    if (nch > 4) load_chunk(4, r0);
    __syncthreads();
    const int tm = wid & 3, tn0 = 4 * (wid >> 2);
    f32x4 acc[4];
#define SB_STEP(c, RN) do { \
        const LAS unsigned char* B = lds + (((c) & 1) ? SB_B1 : SB_B0); \
        _Pragma("unroll") for (int q = 0; q < 4; ++q) acc[q] = (f32x4){0.f, 0.f, 0.f, 0.f}; \
        _Pragma("unroll") for (int ks = 0; ks < 4; ++ks) { \
            const bf16x8 xa = *(const LAS bf16x8*)(lds + SB_A + (16 * tm + (lane & 15)) * 272 + (32 * ks + 8 * (lane >> 4)) * 2); \
            _Pragma("unroll") for (int q = 0; q < 4; ++q) { const bf16x8 yb = *(const LAS bf16x8*)(B + (16 * (tn0 + q) + (lane & 15)) * 272 + (32 * ks + 8 * (lane >> 4)) * 2); \
                acc[q] = __builtin_amdgcn_mfma_f32_16x16x32_bf16(xa, yb, acc[q], 0, 0, 0); } } \
        const int i0 = 16 * tm + 4 * (lane >> 4); \
        if (wid < 4) { _Pragma("unroll") for (int q = 0; q < 4; ++q) { const int t = 16 * q + (lane & 15); *(f32x4*)(Y + (size_t)(row0 + (c) * CL + t) * 512 + h * 64 + i0) = acc[q]; } } \
        __syncthreads(); \
        if (wid >= 4) { \
            _Pragma("unroll") for (int q = 0; q < 4; ++q) { const int kq = 16 * q + (lane & 15); _Pragma("unroll") for (int r = 0; r < 4; ++r) AI[(i0 + r) * 136 + kq] = (bf16_t)f2bf(acc[q][r]); } \
            if ((c) == nch - 1) { _Pragma("unroll") for (int q = 0; q < 4; ++q) { const int kq = 16 * q + (lane & 15); _Pragma("unroll") for (int r = 0; r < 4; ++r) Sout[(size_t)(i0 + r) * 64 + kq] = acc[q][r]; } } } \
        if ((c) + 1 < nch) store_chunk((c) + 1, RN); \
        if ((c) + 5 < nch && (c) + 5 >= ready) SB_WAIT_BATCH(); \
        __syncthreads(); \
        if ((c) + 5 < nch) load_chunk((c) + 5, RN); } while (0)
    for (int c = 0; c < nch; c += 4) {
        SB_STEP(c, r1);
        if (c + 1 < nch) SB_STEP(c + 1, r2);
        if (c + 2 < nch) SB_STEP(c + 2, r3);
        if (c + 3 < nch) SB_STEP(c + 3, r0);
    }
#undef SB_STEP
#undef SB_WAIT_BATCH
}

constexpr int AT_K0 = 0, AT_K1 = 9216, AT_V0 = 18432, AT_V1 = 30720, AT_NB0 = 43008, AT_NB1 = 43264, AT_WSF = 43520, AT_CNT = 45568;
__device__ __forceinline__ void attn_unit(LAS unsigned char* lds, const bf16_t* Q, int ldq, const bf16_t* K, const bf16_t* V, int ldkv, const float* lc2,
                                          bf16_t* O, int ldo, int nq_valid, int qpos0, float U2x2, float T2) {
    const int tid = threadIdx.x, lane = tid & 63, r32 = lane & 31, hi = lane >> 5, wid = __builtin_amdgcn_readfirstlane(tid >> 6);
    const int jmax = (qpos0 + nq_valid - 1) >> 6, ntile = jmax + 1;
    LAS float* wsf = (LAS float*)(lds + AT_WSF) + wid * 64; LAS int* cnt = (LAS int*)(lds + AT_CNT);
    const float Lq0 = lc2[qpos0];
    bool drop = false;
    if (tid < ntile) { const int kend = 64 * tid + 63; if (kend <= qpos0) drop = (Lq0 - lc2[kend] + U2x2 < -T2); }
    { const unsigned long long bal = __ballot(drop); if (lane == 0) cnt[wid] = __popcll(bal); }
    __syncthreads();
    int tlo = 0;
#pragma unroll
    for (int w = 0; w < 8; ++w) tlo += cnt[w];
    const float Lref = lc2[64 * tlo];
    const bool active = 32 * wid < nq_valid;
    const int qp_lo = qpos0 + 32 * wid, qp_hi = qp_lo + 31, qpos = qp_lo + r32;
    const float Lqw = active ? lc2[qp_lo] - Lref : 0.f;
    bf16x8 qr[4];
    if (active) {
#pragma unroll
        for (int d0 = 0; d0 < 4; ++d0) qr[d0] = *(const bf16x8*)(Q + (size_t)(32 * wid + r32) * ldq + d0 * 16 + hi * 8);
    } else {
#pragma unroll
        for (int d0 = 0; d0 < 4; ++d0) qr[d0] = (bf16x8){0, 0, 0, 0, 0, 0, 0, 0};
    }
    float m_run = -1e30f, l_run = 0.f; f32x16 o0 = {}, o1 = {};
    const int srow = tid >> 3, sch = tid & 7;
    u32x4 kreg, vreg; float nbreg = 0.f;
    auto load_tile = [&](int j) {
        kreg = *(const u32x4*)(K + (size_t)(64 * j + srow) * ldkv + 8 * sch); vreg = *(const u32x4*)(V + (size_t)(64 * j + srow) * ldkv + 8 * sch);
        if (tid < 64) nbreg = Lref - lc2[64 * j + tid]; };
    auto store_tile = [&](int b) {
        *(LAS u32x4*)(lds + (b ? AT_K1 : AT_K0) + srow * 144 + sch * 16) = kreg; *(LAS u32x4*)(lds + (b ? AT_V1 : AT_V0) + srow * 192 + sch * 16) = vreg;
        if (tid < 64) ((LAS float*)(lds + (b ? AT_NB1 : AT_NB0)))[tid] = nbreg; };
    load_tile(jmax); store_tile(0);
    __syncthreads();
    int buf = 0;
    for (int j = jmax; j >= tlo; --j) {
        if (j > tlo) load_tile(j - 1);
        const LAS unsigned char* Kt = lds + (buf ? AT_K1 : AT_K0); const LAS unsigned char* Vt = lds + (buf ? AT_V1 : AT_V0); const LAS float* NB = (const LAS float*)(lds + (buf ? AT_NB1 : AT_NB0));
        bool need = active && (64 * j <= qp_hi);
        if (need && (64 * j + 63 < qp_lo)) need = (Lqw + NB[63] + U2x2 >= -T2);
        if (need) {
            f32x16 p0 = {}, p1 = {};
#pragma unroll
            for (int d0 = 0; d0 < 4; ++d0) { const bf16x8 a0 = *(const LAS bf16x8*)(Kt + r32 * 144 + d0 * 32 + hi * 16), a1 = *(const LAS bf16x8*)(Kt + (32 + r32) * 144 + d0 * 32 + hi * 16);
                p0 = __builtin_amdgcn_mfma_f32_32x32x16_bf16(a0, qr[d0], p0, 0, 0, 0); p1 = __builtin_amdgcn_mfma_f32_32x32x16_bf16(a1, qr[d0], p1, 0, 0, 0); }
#pragma unroll
            for (int aa = 0; aa < 4; ++aa) { const f32x4 n0 = *(const LAS f32x4*)(NB + 8 * aa + 4 * hi), n1 = *(const LAS f32x4*)(NB + 32 + 8 * aa + 4 * hi);
#pragma unroll
                for (int b = 0; b < 4; ++b) { p0[4 * aa + b] += n0[b]; p1[4 * aa + b] += n1[b]; } }
            if (64 * j + 63 > qp_lo) {
#pragma unroll
                for (int r = 0; r < 16; ++r) { const int key = 64 * j + (r & 3) + 8 * (r >> 2) + 4 * hi; if (key > qpos) p0[r] = -1e30f; if (key + 32 > qpos) p1[r] = -1e30f; }
            }
            float rm = fmaxf(p0[0], p1[0]);
#pragma unroll
            for (int r = 1; r < 16; ++r) rm = fmaxf(rm, fmaxf(p0[r], p1[r]));
            rm = fmaxf(rm, __shfl_xor(rm, 32));
            if (__any(rm > m_run)) {
                const float mn = fmaxf(m_run, rm), f = __builtin_amdgcn_exp2f(m_run - mn); l_run *= f; m_run = mn;
                if (hi == 0) wsf[r32] = f;
                asm volatile("s_waitcnt lgkmcnt(0)" ::: "memory");
#pragma unroll
                for (int aa = 0; aa < 4; ++aa) { const f32x4 f4 = *(const LAS f32x4*)(wsf + 8 * aa + 4 * hi);
#pragma unroll
                    for (int b = 0; b < 4; ++b) { o0[4 * aa + b] *= f4[b]; o1[4 * aa + b] *= f4[b]; } }
            }
            float ls = 0.f;
#pragma unroll
            for (int r = 0; r < 16; ++r) { p0[r] = __builtin_amdgcn_exp2f(p0[r] - m_run); p1[r] = __builtin_amdgcn_exp2f(p1[r] - m_run); ls += p0[r] + p1[r]; }
            l_run += ls;
            bf16x8 pa[4];
#pragma unroll
            for (int s = 0; s < 4; ++s) { u32x4 w;
                if (s < 2) { w.x = pk2(p0[8 * s + 0], p0[8 * s + 1]); w.y = pk2(p0[8 * s + 2], p0[8 * s + 3]); w.z = pk2(p0[8 * s + 4], p0[8 * s + 5]); w.w = pk2(p0[8 * s + 6], p0[8 * s + 7]); }
                else { const int s2 = s - 2; w.x = pk2(p1[8 * s2 + 0], p1[8 * s2 + 1]); w.y = pk2(p1[8 * s2 + 2], p1[8 * s2 + 3]); w.z = pk2(p1[8 * s2 + 4], p1[8 * s2 + 5]); w.w = pk2(p1[8 * s2 + 6], p1[8 * s2 + 7]); }
                pa[s] = __builtin_bit_cast(bf16x8, w); }
            const LAS unsigned char* vb = Vt + (4 * hi + ((lane & 15) >> 2)) * 192 + (16 * ((lane >> 4) & 1) + 4 * (lane & 3)) * 2;
#pragma unroll
            for (int s = 0; s < 4; ++s) { const int kvb = (s & 1) * 16 + (s >> 1) * 32;
#pragma unroll
                for (int dh = 0; dh < 2; ++dh) { const LAS unsigned char* p = vb + kvb * 192 + dh * 64;
                    const v4i16_t lo = __builtin_amdgcn_ds_read_tr16_b64_v4i16((LAS v4i16_t*)p), hi4 = __builtin_amdgcn_ds_read_tr16_b64_v4i16((LAS v4i16_t*)(p + 8 * 192));
                    const bf16x8 bv = (bf16x8){lo[0], lo[1], lo[2], lo[3], hi4[0], hi4[1], hi4[2], hi4[3]};
                    if (dh == 0) o0 = __builtin_amdgcn_mfma_f32_32x32x16_bf16(pa[s], bv, o0, 0, 0, 0); else o1 = __builtin_amdgcn_mfma_f32_32x32x16_bf16(pa[s], bv, o1, 0, 0, 0); } }
        }
        if (j > tlo) store_tile(buf ^ 1);
        __syncthreads();
        buf ^= 1;
    }
    if (active) {
        const float lt = l_run + __shfl_xor(l_run, 32);
        if (hi == 0) wsf[32 + r32] = 1.0f / lt;
        asm volatile("s_waitcnt lgkmcnt(0)" ::: "memory");
#pragma unroll
        for (int aa = 0; aa < 4; ++aa) { const f32x4 i4 = *(const LAS f32x4*)(wsf + 32 + 8 * aa + 4 * hi);
#pragma unroll
            for (int b = 0; b < 4; ++b) { const int q = 32 * wid + 8 * aa + 4 * hi + b; bf16_t* op = O + (size_t)q * ldo + r32;
                op[0] = (bf16_t)f2bf(o0[4 * aa + b] * i4[b]); op[32] = (bf16_t)f2bf(o1[4 * aa + b] * i4[b]); } }
    }
    __syncthreads();
}

__device__ __forceinline__ void phase5(const Args& a, LAS unsigned char* lds) {
    const int tid = threadIdx.x, lane = tid & 63;
    unsigned char* ws = a.ws;
    float gq = fabsf(a.in[24][lane]), gk = fabsf(a.in[25][lane]);
#pragma unroll
    for (int o = 1; o < 64; o <<= 1) { gq = fmaxf(gq, __shfl_xor(gq, o)); gk = fmaxf(gk, __shfl_xor(gk, o)); }
    const float U2x2 = 2.0f * 8.0f * gq * gk * LOG2E * 1.03f + 0.5f, T2 = 20.0f * LOG2E;
    unsigned* ctr = (unsigned*)(ws + WS_CTL) + 64; LAS unsigned* su = (LAS unsigned*)(lds + AT_CNT + 64);
    bf16_t* PF = (bf16_t*)(ws + WS_PF);
    for (;;) {
        if (tid == 0) *su = atomicAdd(ctr, 1u);
        __syncthreads();
        const unsigned u = *su;
        __syncthreads();
        if (u >= 1024u + 64u) break;
        if (u < 1024u) { const int bh = u >> 5, qb = u & 31, b = bh >> 3, h = bh & 7; bf16_t* base = PF + (size_t)(b * TP) * RC + h * 64;
            attn_unit(lds, base + (size_t)(256 * qb) * RC, RC, base + 512, base + 1024, RC, (const float*)(ws + WS_LCP) + (size_t)bh * TP, base + (size_t)(256 * qb) * RC, RC, 256, 256 * qb, U2x2, T2); }
        else { const int bh = u - 1024, b = bh >> 3, h = bh & 7; bf16_t* qb_ = PF + (size_t)(MP + b * TS) * RC + h * 64;
            attn_unit(lds, qb_, RC, (const bf16_t*)(ws + WS_KS) + (size_t)b * NKS * 512 + h * 64, (const bf16_t*)(ws + WS_VS) + (size_t)b * NKS * 512 + h * 64, 512,
                      (const float*)(ws + WS_LCS) + (size_t)bh * NKS, qb_, RC, TS, PAST, U2x2, T2); }
    }
}

__device__ __forceinline__ void phase6(const Args& a, const pg8::RowSet rs, int rank, int pool, int opq) {
    const int tidq = threadIdx.x + opq; const int lane = tidq & 63, gw = rank * 8 + (tidq >> 6), NGW = pool * 8;
    unsigned char* ws = a.ws;
    const bf16_t* PR = (const bf16_t*)(ws + WS_PR); bf16_t* PF = (bf16_t*)(ws + WS_PF); const bf16_t* AG = (const bf16_t*)(ws + WS_AG);
    const float* Y = (const float*)(ws + WS_Y); const float* RK = (const float*)(ws + WS_RK);
    const int c = 8 * lane, nr = rs.nrows();
    struct P6Regs { f32x4 y0, y1; u32x4 pv, qv, g; float rk; };
    P6Regs nx;
    auto ldrow = [&](int r) { const int m = rs.grow(r);
        nx.y0 = *(const f32x4*)(Y + (size_t)m * 512 + c); nx.y1 = *(const f32x4*)(Y + (size_t)m * 512 + c + 4);
        nx.pv = *(const u32x4*)(PR + (size_t)m * RC + 1024 + c); nx.qv = *(const u32x4*)(PR + (size_t)(m > 0 ? m - 1 : 0) * RC + 1024 + c);
        nx.g = *(const u32x4*)(AG + (size_t)m * 1024 + 512 + c); nx.rk = RK[(size_t)m * 8 + (lane >> 3)]; };
    if (gw < nr) ldrow(gw);
    for (int r = gw; r < nr; r += NGW) {
        const int m = rs.grow(r);
        const bool samp = m >= MP; const int ml = samp ? m - MP : m; const int b = samp ? (ml >> 6) : (ml >> 13); const int t = samp ? (ml & 63) : (ml & 8191);
        const P6Regs cu = nx;
        if (r + NGW < nr) ldrow(r + NGW);
        const f32x4 y0 = cu.y0, y1 = cu.y1;
        float y[8] = {y0[0], y0[1], y0[2], y0[3], y1[0], y1[1], y1[2], y1[3]}; float s = 0.f;
#pragma unroll
        for (int j = 0; j < 8; ++j) s += y[j];
        const float mean = sum8(s) * (1.f / 64.f); float q = 0.f;
#pragma unroll
        for (int j = 0; j < 8; ++j) { y[j] -= mean; q += y[j] * y[j]; }
        const float rstd = rsqrtf(sum8(q) * (1.f / 64.f) + 64e-5f);
        float pv[8], qv[8], g[8]; unpack8(cu.pv, pv);
        if (t > 0) unpack8(cu.qv, qv);
        else {
#pragma unroll
            for (int j = 0; j < 8; ++j) qv[j] = samp ? a.in[6][(size_t)b * RC + 1024 + c + j] : 0.f; }
        unpack8(cu.g, g);
        const float rk = cu.rk; float o[8];
#pragma unroll
        for (int j = 0; j < 8; ++j) { const float zv = pv[j] + (qv[j] - pv[j]) * a.in[13][1024 + c + j]; o[j] = (y[j] * rstd * a.in[22][c + j] + a.in[23][c + j] + rk * zv) * g[j]; }
        *(u32x4*)(PF + (size_t)m * RC + 512 + c) = pack8(o);
    }
}
__device__ __forceinline__ void norm2_rows(const Args& a, const pg8::RowSet rs, int rank, int pool, const float* X1b, bf16_t* H2b, const float* mod, int opq) {
    const int tidq = threadIdx.x + opq; const int lane = tidq & 63, gw = rank * 8 + (tidq >> 6), NGW = pool * 8, nr = rs.nrows();
    const float* gvec = a.in[28];
    f32x4 nx[4];
    auto ldrow = [&](int r) { const float* xr = X1b + (size_t)rs.grow(r) * DM;
#pragma unroll
        for (int j = 0; j < 4; ++j) nx[j] = *(const f32x4*)(xr + 4 * lane + 256 * j); };
    if (gw < nr) ldrow(gw);
    for (int r = gw; r < nr; r += NGW) {
        const int m = rs.grow(r); const size_t br = (size_t)rs.brow(r);
        const float* mr = mod + (size_t)batch_of_row(m) * 6144;
        f32x4 v[4]; float s = 0.f;
#pragma unroll
        for (int j = 0; j < 4; ++j) { v[j] = nx[j]; s += (v[j][0] * v[j][0] + v[j][1] * v[j][1]) + (v[j][2] * v[j][2] + v[j][3] * v[j][3]); }
        if (r + NGW < nr) ldrow(r + NGW);
        const float rinv = rsqrtf(wave_sum(s) * (1.f / DM) + 1e-6f);
#pragma unroll
        for (int j = 0; j < 4; ++j) { const int c = 4 * lane + 256 * j; const f32x4 g = *(const f32x4*)(gvec + c), sc = *(const f32x4*)(mr + 4096 + c), sh = *(const f32x4*)(mr + 3072 + c);
            f32x4 o;
#pragma unroll
            for (int q = 0; q < 4; ++q) o[q] = v[j][q] * rinv * g[q] * (1.f + sc[q]) + sh[q];
            u32x2 w; w.x = pk2(o[0], o[1]); w.y = pk2(o[2], o[3]); *(u32x2*)(H2b + br * DM + c) = w; }
    }
}

constexpr int NPHASE = 6;

__global__ void __launch_bounds__(512, 2) mk_fwd(Args a) {
    extern __shared__ __attribute__((aligned(16))) unsigned char lds_raw[];
    LAS unsigned char* lds = (LAS unsigned char*)lds_raw;
    cg::grid_group grid = cg::this_grid();
#define GRID_BAR() do { XcdBarrier xb_; xb_.bar = (unsigned*)(a.ws + WS_CTL) + 6000; xb_.x = xb_xcc_id(); xb_.st = (volatile LAS unsigned*)(lds + 147200); xcd_barrier(xb_, false); } while (0)
#define GRID_BAR_FIRST() do { XcdBarrier xb_; xb_.bar = (unsigned*)(a.ws + WS_CTL) + 6000; xb_.x = xb_xcc_id(); xb_.st = (volatile LAS unsigned*)(lds + 147200); xcd_barrier(xb_, true); } while (0)
    unsigned char* ws = a.ws;
    const int lo = a.ph_lo, hi = a.ph_hi, G = gridDim.x, blk = blockIdx.x;
#define IN(k) (lo <= (k) && (k) < hi)
#define SEAM(k) do { if (IN(k) && IN((k) + 1)) { if (lo < 0) grid.sync(); else if ((k) == lo) GRID_BAR_FIRST(); else GRID_BAR(); } } while (0)
    float* mod = (float*)(ws + WS_MOD);
    if (IN(0)) { for (int rep = 0; rep < REP_ROWS; ++rep) phase0(a, lds); } SEAM(0);
    if (IN(1)) { for (int rep = 0; rep < REP_ROWS; ++rep) norm_rows(a.in[0], a.in[1], a.in[9], mod, 0, 1024, (bf16_t*)(ws + WS_XN)); } SEAM(1);
    if (IN(2)) { pg8::Gemm g{(const bf16_t*)(ws + WS_XN), (const bf16_t*)(ws + WS_WIN), MT, NPAD, 1024, 1024}; pg8::StaticOrder S; S.init(MT, NPAD, G, blk);
        pg8::EpiProj E{(bf16_t*)(ws + WS_PR), (bf16_t*)(ws + WS_PF)}; pg8::gemm_phase<pg8::EpiProj, pg8::StaticOrder, true>(lds, g, S, E); } SEAM(2);
    if (IN(3)) { phase3(a); } SEAM(3);
    if (IN(4)) {
        {
            const int it = (G >= 12) ? blk - (G - 12) : -1;
            if (it >= 0) {
                const bool pr = it < 4; const int b = pr ? it : it - 4;
                const float* sA = pr ? a.out + O_LFP + (size_t)b * TP * 8 : a.in[4] + (size_t)b * PAST * 8;
                const float* sB = a.out + O_LFS + (size_t)b * TS * 8;
                float* dst = pr ? (float*)(ws + WS_LCP) + (size_t)b * 8 * TP : (float*)(ws + WS_LCS) + (size_t)b * 8 * NKS;
                cumsum_block(lds, sA, pr ? TP : PAST, sB, pr ? TP : NKS, pr ? 16 : 8, dst);
            }
        }
        pg8::Gemm g{(const bf16_t*)(ws + WS_A2), (const bf16_t*)(ws + WS_WL), MT, 1536, 256, 256}; pg8::StaticOrder S; S.init(MT, 1536, G, blk);
        pg8::EpiLora E{(float*)(ws + WS_WDEC), (bf16_t*)(ws + WS_AG), a.in[14], a.in[16]}; pg8::gemm_phase<pg8::EpiLora, pg8::StaticOrder, true>(lds, g, S, E); } SEAM(4);
    if (IN(5)) {
        unsigned* ctl = (unsigned*)(ws + WS_CTL);
        if (blk < 32) {
            const int bh = blk, b = bh >> 3;
            sb_chain(a, lds, bh * NCH, NCH, b * TP, bh & 7, nullptr, a.out + O_STP + (size_t)bh * 4096, nullptr);
        } else {
            const int NSA = G - 32;
#define SA_ITEM_OF(q) ((q) < 64 ? 32 * NCH + (q) : (((q) - 64) & 31) * NCH + (((q) - 64) >> 5))
            int prev = -1; SaRegs cur, nxt; if (blk - 32 < SA_ITEMS) sa_load(a, SA_ITEM_OF(blk - 32), cur);
            for (int q = blk - 32; q < SA_ITEMS; q += NSA) { if (q + NSA < SA_ITEMS) sa_load(a, SA_ITEM_OF(q + NSA), nxt); sa_item(a, lds, SA_ITEM_OF(q), cur, prev); prev = SA_ITEM_OF(q); cur = nxt; }
            if (prev >= 0) { asm volatile("s_waitcnt vmcnt(0)" ::: "memory"); __syncthreads();
                if (threadIdx.x == 0) __hip_atomic_store(ctl + 1024 + prev, 1u, __ATOMIC_RELAXED, __HIP_MEMORY_SCOPE_AGENT); }
#undef SA_ITEM_OF
            if (blk < 96) { const int bh = blk - 32, b = bh >> 3;
                sb_chain(a, lds, 32 * NCH + bh, 1, MP + b * TS, bh & 7, a.in[5] + (size_t)bh * 4096, a.out + O_STS + (size_t)bh * 4096, a.in[6] + (size_t)b * RC); }
        }
        phase5(a, lds);
        GRID_BAR();
        {
            const pg8::RowSet rs{1, 0}; const int pool = G, rank = blk; unsigned* bw = ctl + 808;
            float* X1b = a.out + O_Y; bf16_t* H2b = (bf16_t*)(ws + WS_XN); bf16_t* ACTb = (bf16_t*)(ws + WS_ACT);
            phase6(a, rs, rank, pool, 0);
            GRID_BAR();
            { pg8::Gemm g{(const bf16_t*)(ws + WS_PF), (const bf16_t*)(ws + WS_WO), MT, 1024, 1024, RC}; pg8::MapOrder S{rs, 4, pool, rank, 1};
              pg8::EpiResid E{a.in[0], a.in[1], nullptr, X1b, nullptr, mod + 2048}; pg8::gemm_phase<pg8::EpiResid, pg8::MapOrder, true>(lds, g, S, E); }
            GRID_BAR();
            norm2_rows(a, rs, rank, pool, X1b, H2b, mod, 0);
            GRID_BAR();
            { pg8::Gemm g{H2b, (const bf16_t*)(ws + WS_WGU), MT, 2 * DFF, 1024, 1024}; pg8::MapOrder S{rs, 22, pool, rank, 0};
              pg8::EpiSwiglu E{ACTb}; pg8::gemm_phase<pg8::EpiSwiglu, pg8::MapOrder, true>(lds, g, S, E); }
            GRID_BAR();
            { pg8::Gemm g{ACTb, (const bf16_t*)(ws + WS_WD), MT, 1024, DFF, DFF}; pg8::MapOrder S{rs, 4, pool, rank, 0};
              pg8::EpiResid E{X1b, X1b + (size_t)MP * DM, nullptr, X1b, nullptr, mod + 5120}; pg8::gemm_phase<pg8::EpiResid, pg8::MapOrder, true>(lds, g, S, E); }
        }
    }
#undef IN
#undef SEAM
}

#ifndef MK_N_LAUNCHES
#define MK_N_LAUNCHES 1
#endif
extern "C" void kernel_launch(void* const* d_in, const int* in_sizes, int n_in, void* d_out, int out_size, void* d_ws, size_t ws_size, hipStream_t stream) {
    static int grid = 0;
    if (grid == 0) {
        if (n_in != 32 || ws_size < WS_END) { fprintf(stderr, "kernel_launch: unexpected n_in %d / ws %zu\n", n_in, ws_size); grid = -1; return; }
        int dev = 0, cus = 0, per_cu = 0;
        hipGetDevice(&dev); hipDeviceGetAttribute(&cus, hipDeviceAttributeMultiprocessorCount, dev);
        hipFuncSetAttribute((const void*)mk_fwd, hipFuncAttributeMaxDynamicSharedMemorySize, LDS_BYTES);
        hipOccupancyMaxActiveBlocksPerMultiprocessor(&per_cu, (const void*)mk_fwd, 512, LDS_BYTES);
        (void)hipGetLastError();
        if (per_cu < 1) per_cu = 1;
        grid = cus;
        if (grid < 1) grid = 256;
    }
    if (grid < 0) return;
    hipMemsetAsync((char*)d_ws + WS_CTL, 0, 40960, stream);
    Args a{};
    for (int i = 0; i < 32; ++i) a.in[i] = (const float*)d_in[i];
    a.out = (float*)d_out; a.ws = (unsigned char*)d_ws;
    if (MK_N_LAUNCHES == 1) {
        a.ph_lo = 0; a.ph_hi = NPHASE; void* args[] = {&a};
        hipError_t e = hipLaunchCooperativeKernel((const void*)mk_fwd, dim3(grid), dim3(512), args, LDS_BYTES, stream);
        if (e != hipSuccess) fprintf(stderr, "cooperative launch failed: %s (grid %d)\n", hipGetErrorString(e), grid);
    } else {
        for (int p = 0; p < NPHASE; ++p) { a.ph_lo = p; a.ph_hi = p + 1; hipLaunchKernelGGL(mk_fwd, dim3(grid), dim3(512), LDS_BYTES, stream, a); }
    }
}
```
